# Optimizing an MI355X kernel written in HIP

```python
import jax, jax.numpy as jnp
from jax import lax
import numpy as np

D_MODEL = 1024
BATCH = 4
SEQ = 4096
DEPTH = 1
DEC_BATCH = 32
DEC_SEQ = 1
PAST_LEN = 8192
PAGE_SIZE = 128

N_META = 16
D_MIX = D_MODEL
D_ATTN = D_MIX // 2
H_A = 8
DH = D_ATTN // H_A
D_POOL = D_MIX - D_ATTN
POOL_WINDOWS = (2, 4, 8, 16)
POOL_GROUPS = len(POOL_WINDOWS)
POOL_CH = D_POOL // POOL_GROUPS
POOL_STATE = max(POOL_WINDOWS) - 1
D_FF = 2816
CONV_W = 3
Q_BLOCK = 128
EPS = 1e-6
ATTN_SCALE = DH ** -0.5
SB_BIAS_INIT = -7.0

kernel_name = "hymba_stickbreak_pool_convffn_step"


def rmsnorm(x, g):
    xf = x.astype(jnp.float32)
    r = lax.rsqrt(jnp.mean(xf * xf, axis=-1, keepdims=True) + EPS)
    return (xf * r * g.astype(jnp.float32)).astype(x.dtype)


def stick_breaking(q, k, v, q_pos, k_pos, sb_bias):
    z = jnp.einsum('bqhd,bkhd->bhqk', q.astype(jnp.float32), k.astype(jnp.float32)) * ATTN_SCALE
    z = z + sb_bias.astype(jnp.float32)[None, :, None, None]
    valid = k_pos[None, :] < q_pos[:, None]
    neg = jnp.where(valid, -jax.nn.softplus(z), 0.0)
    suffix = lax.cumsum(neg, axis=3, reverse=True) - neg
    a = jnp.where(valid, jnp.exp(jax.nn.log_sigmoid(z) + suffix), 0.0)
    o = jnp.einsum('bhqk,bkhd->bqhd', a, v.astype(jnp.float32))
    return o.astype(q.dtype)


def multiscale_pool(u, p0, n_keep, pool_w, pool_scale):
    B, L, _ = u.shape
    uf = u.astype(jnp.float32).reshape(B, L, POOL_GROUPS, POOL_CH)
    csum = jnp.cumsum(uf, axis=1)
    pos = p0 + jnp.arange(L)
    diffs = []
    for g, w in enumerate(POOL_WINDOWS):
        c = csum[:, :, g]
        lagged = jnp.pad(c, ((0, 0), (w, 0), (0, 0)))[:, :L]
        cnt = jnp.minimum(w, pos + 1).astype(jnp.float32)
        diffs.append((c - lagged) / cnt[None, :, None] - uf[:, :, g])
    d = jnp.stack(diffs, axis=2)[:, L - n_keep:]
    out = jnp.einsum('blgc,gce->blge', d, pool_w.astype(jnp.float32)) * pool_scale.astype(jnp.float32)
    return out.reshape(B, n_keep, D_POOL).astype(u.dtype)


def project_mix(h, w_in):
    B, L, _ = h.shape
    p = h @ w_in
    q = p[..., :D_ATTN].reshape(B, L, H_A, DH)
    k = p[..., D_ATTN:2 * D_ATTN].reshape(B, L, H_A, DH)
    v = p[..., 2 * D_ATTN:3 * D_ATTN].reshape(B, L, H_A, DH)
    u = p[..., 3 * D_ATTN:]
    return q, k, v, u


def conv_ffn(h, prefix, w_up, conv_w, conv_b, w_down):
    up = h @ w_up
    L = up.shape[1]
    ext = jnp.concatenate([prefix.astype(up.dtype), up], axis=1)
    c = conv_b + sum(conv_w[i] * ext[:, i:i + L] for i in range(CONV_W))
    gate, val = c[..., :D_FF], c[..., D_FF:]
    out = (jax.nn.silu(gate) * val) @ w_down
    return out, ext[:, L + 2 - (CONV_W - 1):]


def setup_inputs(seed: int = 0) -> dict:
    key = jax.random.key(seed)
    ks = jax.random.split(key, 24)
    n_pages = PAST_LEN // PAGE_SIZE
    n_used = DEC_BATCH * n_pages
    n_pool = n_used + n_used // 4
    f32 = jnp.float32
    nrm = lambda k, shape, s: jax.random.normal(k, shape, f32) * s
    perm = jax.random.permutation(ks[0], n_pool)[:n_used]
    page_table = perm.reshape(DEC_BATCH, n_pages).astype(jnp.int32)
    return {
        "x_prompt": nrm(ks[1], (BATCH, SEQ, D_MODEL), 1.0),
        "x_sample": nrm(ks[2], (DEC_BATCH, DEC_SEQ, D_MODEL), 1.0),
        "cache_k": nrm(ks[3], (n_pool, PAGE_SIZE, H_A, DH), 1.0),
        "cache_v": nrm(ks[4], (n_pool, PAGE_SIZE, H_A, DH), 1.0),
        "state_pool": nrm(ks[5], (DEC_BATCH, POOL_STATE, D_POOL), 1.0),
        "state_conv": nrm(ks[6], (DEC_BATCH, CONV_W - 1, 2 * D_FF), 1.0),
        "page_table": page_table,
        "meta_tokens": nrm(ks[7], (N_META, D_MODEL), 1.0),
        "norm_mix_g": 1.0 + nrm(ks[8], (D_MODEL,), 0.05),
        "w_in": nrm(ks[9], (D_MODEL, 3 * D_ATTN + D_POOL), D_MODEL ** -0.5),
        "sb_bias": SB_BIAS_INIT + nrm(ks[19], (H_A,), 0.1),
        "pool_w": nrm(ks[10], (POOL_GROUPS, POOL_CH, POOL_CH), POOL_CH ** -0.5),
        "pool_scale": 1.0 + nrm(ks[11], (POOL_GROUPS, POOL_CH), 0.1),
        "w_out": nrm(ks[12], (D_MIX, D_MODEL), D_MIX ** -0.5),
        "norm_ffn_g": 1.0 + nrm(ks[13], (D_MODEL,), 0.05),
        "w_up": nrm(ks[14], (D_MODEL, 2 * D_FF), D_MODEL ** -0.5),
        "conv_w": nrm(ks[15], (CONV_W, 2 * D_FF), CONV_W ** -0.5),
        "conv_b": nrm(ks[16], (2 * D_FF,), 0.02),
        "w_down": nrm(ks[17], (D_FF, D_MODEL), D_FF ** -0.5),
        "norm_final_g": 1.0 + nrm(ks[18], (D_MODEL,), 0.05),
    }


def reference(x_prompt, x_sample, cache_k, cache_v, state_pool, state_conv, page_table,
              meta_tokens, norm_mix_g, w_in, sb_bias, pool_w, pool_scale, w_out, norm_ffn_g,
              w_up, conv_w, conv_b, w_down, norm_final_g):
    B = x_prompt.shape[0]
    T = N_META + SEQ
    n_blocks = SEQ // Q_BLOCK

    meta = jnp.broadcast_to(meta_tokens.astype(x_prompt.dtype)[None], (B, N_META, D_MODEL))
    xp = jnp.concatenate([meta, x_prompt], axis=1)
    for _ in range(DEPTH):
        h = rmsnorm(xp, norm_mix_g)
        q, k, v, u = project_mix(h, w_in)
        k_prompt, v_prompt = k, v
        k_pos = jnp.arange(T)
        o_meta = stick_breaking(q[:, :N_META], k[:, :N_META], v[:, :N_META],
                                jnp.arange(N_META), jnp.arange(N_META), sb_bias)
        q_blk = q[:, N_META:].reshape(B, n_blocks, Q_BLOCK, H_A, DH).transpose(1, 0, 2, 3, 4)
        qpos_blk = (N_META + jnp.arange(SEQ)).reshape(n_blocks, Q_BLOCK)
        o_real = lax.map(lambda a: stick_breaking(a[0], k, v, a[1], k_pos, sb_bias), (q_blk, qpos_blk))
        o_real = o_real.transpose(1, 0, 2, 3, 4).reshape(B, SEQ, H_A, DH)
        o_attn = jnp.concatenate([o_meta, o_real], axis=1).reshape(B, T, D_ATTN)
        o_pool = multiscale_pool(u, 0, T, pool_w, pool_scale)
        pool_prompt = u[:, T - POOL_STATE:]
        xp = xp + jnp.concatenate([o_attn, o_pool], axis=-1) @ w_out
        h2 = rmsnorm(xp, norm_ffn_g)
        zero_prefix = jnp.zeros((B, CONV_W - 1, 2 * D_FF), xp.dtype)
        f, conv_prompt = conv_ffn(h2, zero_prefix, w_up, conv_w, conv_b, w_down)
        xp = xp + f
    y_prompt = rmsnorm(xp, norm_final_g)[:, N_META:]

    DB, L = x_sample.shape[0], x_sample.shape[1]
    xs = x_sample
    for _ in range(DEPTH):
        h = rmsnorm(xs, norm_mix_g)
        q, k_new, v_new, u_new = project_mix(h, w_in)
        k_sample, v_sample = k_new, v_new
        k_past = cache_k[page_table].reshape(DB, PAST_LEN, H_A, DH)
        v_past = cache_v[page_table].reshape(DB, PAST_LEN, H_A, DH)
        k_all = jnp.concatenate([k_past.astype(k_new.dtype), k_new], axis=1)
        v_all = jnp.concatenate([v_past.astype(v_new.dtype), v_new], axis=1)
        o_attn = stick_breaking(q, k_all, v_all, PAST_LEN + jnp.arange(L),
                                jnp.arange(PAST_LEN + L), sb_bias).reshape(DB, L, D_ATTN)
        u_ext = jnp.concatenate([state_pool.astype(u_new.dtype), u_new], axis=1)
        o_pool = multiscale_pool(u_ext, PAST_LEN - POOL_STATE, L, pool_w, pool_scale)
        pool_sample = u_ext[:, u_ext.shape[1] - POOL_STATE:]
        xs = xs + jnp.concatenate([o_attn, o_pool], axis=-1) @ w_out
        h2 = rmsnorm(xs, norm_ffn_g)
        f, conv_sample = conv_ffn(h2, state_conv, w_up, conv_w, conv_b, w_down)
        xs = xs + f
    y_sample = rmsnorm(xs, norm_final_g)

    return (y_prompt, y_sample, k_prompt, v_prompt, pool_prompt, conv_prompt,
            k_sample, v_sample, pool_sample, conv_sample)
```

```cpp
#include <hip/hip_runtime.h>
#include <stdint.h>
#include <stdio.h>
namespace pg8 {
#define PG8_LAS __attribute__((address_space(3)))
typedef unsigned short bf16_t;
typedef short bf16x8 __attribute__((ext_vector_type(8)));
typedef float f32x4 __attribute__((ext_vector_type(4)));
typedef unsigned u32x4 __attribute__((ext_vector_type(4)));
constexpr int BM = 256, BK = 64, HALF = 128, HTB = HALF * BK * 2  , STAGE_BYTES = 8 * HTB, NXCD = 8, WGM = 8;

__host__ __device__ __forceinline__ int lds_byte(int r, int c) { const int st = (r >> 4) * 2 + (c >> 5), rr = r & 15, cc = c & 31, ob = rr * 64 + cc * 2; return st * 1024 + (ob ^ (((ob >> 9) & 1) << 5)); }
__host__ __device__ __forceinline__ void stage_rc(int b, int& R, int& C) { const int st = b / 1024, sb = b % 1024, swz = sb ^ (((sb >> 9) & 1) << 5); R = (st >> 1) * 16 + swz / 64; C = (st & 1) * 32 + (swz % 64) / 2; }
__host__ __device__ __forceinline__ int perm32(int rho) { const int n = rho >> 4, i = rho & 15; return 8 * (i >> 2) + 4 * n + (i & 3); }

struct Unit { int pm, pn; };
struct Gemm { const bf16_t* A; const bf16_t* Bt; int M, N, K; };

struct StaticOrder {
    int nM, nN, nwg, G, c;
    __host__ __device__ void init(int M, int N, int G_, int c_) { nM = M / BM; nN = N / BM; nwg = nM * nN; G = G_; c = c_; }
    __host__ __device__ bool next(int i, Unit& u) const {
        const long L = (long)i * G + c; if (L >= nwg) return false;
        int wgid = (int)L; { const int q = nwg / NXCD, r = nwg % NXCD, xcd = wgid % NXCD, off = wgid / NXCD; wgid = (xcd < r ? xcd * (q + 1) : r * (q + 1) + (xcd - r) * q) + off; }
        const int nig = WGM * nN, gid = wgid / nig, fm = gid * WGM, gsz = (nM - fm) < WGM ? (nM - fm) : WGM;
        u.pm = fm + ((wgid % nig) % gsz); u.pn = (wgid % nig) / gsz; return true;
    }
    __device__ __forceinline__ void a_ready(const Unit&) const {}
    __device__ __forceinline__ void done(const Unit&) const {}
};

typedef float f32x2 __attribute__((ext_vector_type(2)));
typedef __bf16 bf16x2v __attribute__((ext_vector_type(2)));
typedef unsigned u32x2 __attribute__((ext_vector_type(2)));
__device__ __forceinline__ unsigned cvt_pk_bf16(float lo, float hi) { f32x2 v = {lo, hi}; bf16x2v b = __builtin_convertvector(v, bf16x2v); return __builtin_bit_cast(unsigned, b); }
__device__ __forceinline__ u32x4 pack8(const f32x4 a, const f32x4 b) { u32x4 w; w.x = cvt_pk_bf16(a[0], a[1]); w.y = cvt_pk_bf16(a[2], a[3]); w.z = cvt_pk_bf16(b[0], b[1]); w.w = cvt_pk_bf16(b[2], b[3]); return w; }
__device__ __forceinline__ int perm16(int x) { return (x < 4 || x >= 12) ? x : (x < 8 ? x + 4 : x - 4); }

struct EpiIn {
    static constexpr bool PERM = true, AFTER_DRAIN = false;
    bf16_t* Q; bf16_t* Kb; bf16_t* VT; float* U; float* kout; float* vout; float* poolout; float qscale;
    __device__ __forceinline__ void operator()(const f32x4 (&acc)[2][2][4][2], const Unit& u, int wr, int wc, int fr, int fq) const {
        const int kind = u.pn >> 1;
        const int ccb = (u.pn & 1) * 256 + wc * 32 + 8 * fq;
#pragma unroll
        for (int ai = 0; ai < 2; ++ai)
#pragma unroll
            for (int m = 0; m < 4; ++m) {
                const int row = u.pm * BM + ai * HALF + wr * 64 + m * 16 + fr;
                const int b = row >> 12, t = row & 4095;
#pragma unroll
                for (int bj = 0; bj < 2; ++bj) {
                    const int cc = ccb + bj * HALF;
                    const f32x4 v0 = acc[ai][bj][m][0], v1 = acc[ai][bj][m][1];
                    if (kind == 0) {
                        *(u32x4*)(Q + (size_t)row * 512 + cc) = pack8(v0 * qscale, v1 * qscale);
                    } else if (kind == 3) {
                        float* up = U + (size_t)row * 512 + cc; *(f32x4*)up = v0; *(f32x4*)(up + 4) = v1;
                        if (t >= 4081) { float* po = poolout + ((size_t)(b * 15 + (t - 4081))) * 512 + cc; *(f32x4*)po = v0; *(f32x4*)(po + 4) = v1; }
                    } else {
                        const int head = cc >> 6, d0 = cc & 63;
                        float* o = (kind == 1 ? kout : vout) + ((size_t)(b * 4112 + 16 + t) * 8 + head) * 64 + d0;
                        *(f32x4*)o = v0; *(f32x4*)(o + 4) = v1;
                        if (kind == 1) {
                            *(u32x4*)(Kb + ((size_t)(b * 8 + head) * 4128 + 32 + t) * 64 + d0) = pack8(v0, v1);
                        } else {
                            const int J = 1 + (t >> 5), kl = t & 31, pos = (kl & 16) | perm16(kl & 15);
                            bf16_t* vp = VT + (((size_t)(b * 8 + head) * 129 + J) * 64 + d0) * 32 + pos;
                            const u32x4 w = pack8(v0, v1);
                            vp[0 * 32] = (bf16_t)(w.x & 0xffffu); vp[1 * 32] = (bf16_t)(w.x >> 16); vp[2 * 32] = (bf16_t)(w.y & 0xffffu); vp[3 * 32] = (bf16_t)(w.y >> 16);
                            vp[4 * 32] = (bf16_t)(w.z & 0xffffu); vp[5 * 32] = (bf16_t)(w.z >> 16); vp[6 * 32] = (bf16_t)(w.w & 0xffffu); vp[7 * 32] = (bf16_t)(w.w >> 16);
                        }
                    }
                }
            }
    }
};

struct EpiOut {
    static constexpr bool PERM = false, AFTER_DRAIN = false;
    const float* xres; float* x1f; bf16_t* x1b; float* stat;
    __device__ __forceinline__ void operator()(const f32x4 (&acc)[2][2][4][2], const Unit& u, int wr, int wc, int fr, int fq) const {
#pragma unroll
        for (int ai = 0; ai < 2; ++ai)
#pragma unroll
            for (int m = 0; m < 4; ++m) {
                const int row = u.pm * BM + ai * HALF + wr * 64 + m * 16 + fr;
                float ss = 0.f;
#pragma unroll
                for (int bj = 0; bj < 2; ++bj)
#pragma unroll
                    for (int n = 0; n < 2; ++n) {
                        const int col = u.pn * BM + bj * HALF + wc * 32 + n * 16 + 4 * fq;
                        const size_t off = (size_t)row * 1024 + col;
                        const f32x4 x = acc[ai][bj][m][n] + *(const f32x4*)(xres + off);
                        *(f32x4*)(x1f + off) = x;
                        u32x2 w; w.x = cvt_pk_bf16(x[0], x[1]); w.y = cvt_pk_bf16(x[2], x[3]);
                        *(u32x2*)(x1b + off) = w;
                        ss += (x[0] * x[0] + x[1] * x[1]) + (x[2] * x[2] + x[3] * x[3]);
                    }
                ss += __shfl_xor(ss, 16); ss += __shfl_xor(ss, 32);
                if (fq == 0) stat[(size_t)row * 16 + u.pn * 4 + wc] = ss;
            }
    }
};

__device__ __forceinline__ float row_rstd(const float* stat, int row) {
    const f32x4 a = *(const f32x4*)(stat + (size_t)row * 16), b = *(const f32x4*)(stat + (size_t)row * 16 + 4), c = *(const f32x4*)(stat + (size_t)row * 16 + 8), d = *(const f32x4*)(stat + (size_t)row * 16 + 12);
    const float s = (((a[0] + a[1]) + (a[2] + a[3])) + ((b[0] + b[1]) + (b[2] + b[3]))) + (((c[0] + c[1]) + (c[2] + c[3])) + ((d[0] + d[1]) + (d[2] + d[3])));
    return 1.0f / sqrtf(s * (1.0f / 1024.0f) + 1e-6f);
}

struct EpiUpRaw {
    static constexpr bool PERM = true, AFTER_DRAIN = false;
    bf16_t* UP; const float* stat; float* convp;
    __device__ __forceinline__ void operator()(const f32x4 (&acc)[2][2][4][2], const Unit& u, int wr, int wc, int fr, int fq) const {
#pragma unroll
        for (int ai = 0; ai < 2; ++ai)
#pragma unroll
            for (int m = 0; m < 4; ++m) {
                const int row = u.pm * BM + ai * HALF + wr * 64 + m * 16 + fr;
                const float rs = row_rstd(stat, row);
                const int b = row >> 12, t = row & 4095;
#pragma unroll
                for (int bj = 0; bj < 2; ++bj) {
                    const int pc = u.pn * BM + bj * HALF + wc * 32 + 8 * fq;
                    const f32x4 v0 = acc[ai][bj][m][0] * rs, v1 = acc[ai][bj][m][1] * rs;
                    *(u32x4*)(UP + (size_t)row * 5632 + pc) = pack8(v0, v1);
                    if (t >= 4094) { float* o = convp + ((size_t)(b * 2 + (t - 4094))) * 5632 + bj * 2816 + u.pn * 128 + wc * 32 + 8 * fq; *(f32x4*)o = v0; *(f32x4*)(o + 4) = v1; }
                }
            }
    }
};

struct EpiDown {
    static constexpr bool PERM = false, AFTER_DRAIN = false;
    const float* x1f; float* x2f; float* stat;
    __device__ __forceinline__ void operator()(const f32x4 (&acc)[2][2][4][2], const Unit& u, int wr, int wc, int fr, int fq) const {
#pragma unroll
        for (int ai = 0; ai < 2; ++ai)
#pragma unroll
            for (int m = 0; m < 4; ++m) {
                const int row = u.pm * BM + ai * HALF + wr * 64 + m * 16 + fr;
                float ss = 0.f;
#pragma unroll
                for (int bj = 0; bj < 2; ++bj)
#pragma unroll
                    for (int n = 0; n < 2; ++n) {
                        const int col = u.pn * BM + bj * HALF + wc * 32 + n * 16 + 4 * fq;
                        const size_t off = (size_t)row * 1024 + col;
                        const f32x4 x = acc[ai][bj][m][n] + *(const f32x4*)(x1f + off);
                        *(f32x4*)(x2f + off) = x;
                        ss += (x[0] * x[0] + x[1] * x[1]) + (x[2] * x[2] + x[3] * x[3]);
                    }
                ss += __shfl_xor(ss, 16); ss += __shfl_xor(ss, 32);
                if (fq == 0) stat[(size_t)row * 16 + u.pn * 4 + wc] = ss;
            }
    }
};

template <class Epi, class Sched, bool ALIGN_EPI = false, bool SP2 = false>
__device__ __forceinline__ void gemm_phase(PG8_LAS unsigned char* lds, const Gemm g, const Sched& S, const Epi& E) {
    int tid_ = threadIdx.x; asm volatile("" : "+v"(tid_));
    const int tid = tid_, wid = __builtin_amdgcn_readfirstlane(tid >> 6), lane = tid & 63, wr = wid >> 2, wc = wid & 3, fr = lane & 15, fq = lane >> 4;
    const int K = g.K, nt = K / BK;
    unsigned voffA[2], voffB[2];
#pragma unroll
    for (int i = 0; i < 2; ++i) { int R, C; stage_rc(tid * 16 + i * 8192, R, C); const int Rb = Epi::PERM ? ((R & ~31) + perm32(R & 31)) : R;
        voffA[i] = (unsigned)(R * K + C) * 2u; voffB[i] = (unsigned)(Rb * K + C) * 2u; }
    const size_t kstep = (size_t)(BK * 2);
    const size_t hstep = (size_t)HALF * K * 2;
    const size_t tstep = 2 * hstep;
    const unsigned ldsw = (unsigned)wid * 1024u;
    const int aoff = lds_byte(wr * 64 + fr, fq * 8), boff = lds_byte(wc * 32 + fr, fq * 8);
#define PG8_SA(b, h) (((b) * 2 + (h)) * HTB)
#define PG8_SB(b, h) ((4 + (b) * 2 + (h)) * HTB)
#define PG8_STAGE(bufoff, gbase, voff) do { _Pragma("unroll") for (int _i = 0; _i < 2; ++_i) \
        __builtin_amdgcn_global_load_lds((const unsigned*)((const char*)(gbase) + (voff)[_i]), (PG8_LAS unsigned*)(lds + (bufoff) + ldsw + _i * 8192), 16, 0, 0); } while (0)
#define PG8_LDA(dst, b, h) do { _Pragma("unroll") for (int m = 0; m < 4; ++m) _Pragma("unroll") for (int k = 0; k < 2; ++k) dst[m][k] = *(const PG8_LAS bf16x8*)(lds + PG8_SA(b, h) + aoff + m * 2048 + k * 1024); } while (0)
#define PG8_LDB(dst, b, h) do { _Pragma("unroll") for (int n = 0; n < 2; ++n) _Pragma("unroll") for (int k = 0; k < 2; ++k) dst[n][k] = *(const PG8_LAS bf16x8*)(lds + PG8_SB(b, h) + boff + n * 2048 + k * 1024); } while (0)
#define PG8_MMA(ai, bj, At, Bt) do { __builtin_amdgcn_s_setprio(1); _Pragma("unroll") for (int m = 0; m < 4; ++m) _Pragma("unroll") for (int n = 0; n < 2; ++n) _Pragma("unroll") for (int k = 0; k < 2; ++k) \
        acc[ai][bj][m][n] = __builtin_amdgcn_mfma_f32_16x16x32_bf16(Bt[n][k], At[m][k], acc[ai][bj][m][n], 0, 0, 0); __builtin_amdgcn_s_setprio(0); } while (0)
#define PG8_WAIT_V(n) asm volatile("s_waitcnt vmcnt(" #n ")" ::: "memory")
#define PG8_WAIT_L(n) asm volatile("s_waitcnt lgkmcnt(" #n ")" ::: "memory")
#define PG8_BAR __builtin_amdgcn_s_barrier()
#define PG8_SCHED __builtin_amdgcn_sched_barrier(0)
    Unit cur, nxt; int ui = 0;
    if (!S.next(0, cur)) return;
    f32x4 acc[2][2][4][2];
#pragma unroll
    for (int a = 0; a < 2; ++a)
#pragma unroll
        for (int b = 0; b < 2; ++b)
#pragma unroll
            for (int m = 0; m < 4; ++m)
#pragma unroll
                for (int n = 0; n < 2; ++n) acc[a][b][m][n] = (f32x4){0.f, 0.f, 0.f, 0.f};
    bf16x8 At[4][2], B0[2][2], B1[2][2];
    const char* cA = (const char*)g.A + (size_t)cur.pm * tstep; const char* cB = (const char*)g.Bt + (size_t)cur.pn * tstep;
    S.a_ready(cur);
    if constexpr (SP2) {
        PG8_STAGE(PG8_SB(0, 0), cB, voffB); PG8_STAGE(PG8_SB(0, 1), cB + hstep, voffB); PG8_STAGE(PG8_SA(0, 0), cA, voffA); PG8_STAGE(PG8_SA(0, 1), cA + hstep, voffA);
        if (wr == 1) PG8_BAR;
        PG8_WAIT_V(2); PG8_BAR;
        PG8_STAGE(PG8_SB(1, 0), cB + kstep, voffB); PG8_STAGE(PG8_SA(1, 0), cA + kstep, voffA); PG8_STAGE(PG8_SB(1, 1), cB + hstep + kstep, voffB);
        PG8_WAIT_V(6); PG8_BAR;
    } else {
        PG8_STAGE(PG8_SB(0, 0), cB, voffB); PG8_STAGE(PG8_SA(0, 0), cA, voffA); PG8_STAGE(PG8_SB(0, 1), cB + hstep, voffB); PG8_STAGE(PG8_SA(0, 1), cA + hstep, voffA);
        if (wr == 1) PG8_BAR;
        PG8_WAIT_V(4); PG8_BAR;
        PG8_STAGE(PG8_SB(1, 0), cB + kstep, voffB); PG8_STAGE(PG8_SA(1, 0), cA + kstep, voffA); PG8_STAGE(PG8_SB(1, 1), cB + hstep + kstep, voffB);
        PG8_WAIT_V(6); PG8_BAR;
    }
    for (;;) {
        const bool has_next = S.next(ui + 1, nxt);
        const char* nA = has_next ? (const char*)g.A + (size_t)nxt.pm * tstep : cA; const char* nB = has_next ? (const char*)g.Bt + (size_t)nxt.pn * tstep : cB;
        for (int t = 0; t < nt; t += 2) {
            const bool last = (t == nt - 2);
            const char* a1 = cA + (size_t)(t + 1) * kstep;
            const char* a2 = last ? nA : cA + (size_t)(t + 2) * kstep; const char* b2 = last ? nB : cB + (size_t)(t + 2) * kstep;
            const char* a3 = a2 + kstep; const char* b3 = b2 + kstep;
            if (last && has_next) S.a_ready(nxt);
            if constexpr (SP2) {
            PG8_LDB(B0, 0, 0); PG8_LDB(B1, 0, 1); PG8_SCHED; PG8_LDA(At, 0, 0); PG8_STAGE(PG8_SA(1, 1), a1 + hstep, voffA);
            PG8_WAIT_V(8); PG8_WAIT_L(0); PG8_BAR; PG8_MMA(0, 0, At, B0); PG8_MMA(0, 1, At, B1); PG8_BAR; PG8_SCHED;
            PG8_LDA(At, 0, 1); PG8_STAGE(PG8_SB(0, 0), b2, voffB); PG8_STAGE(PG8_SB(0, 1), b2 + hstep, voffB); PG8_STAGE(PG8_SA(0, 0), a2, voffA);
            PG8_WAIT_V(8); PG8_WAIT_L(0); PG8_BAR; PG8_MMA(1, 0, At, B0); PG8_MMA(1, 1, At, B1); PG8_BAR; PG8_SCHED;
            PG8_LDB(B0, 1, 0); PG8_LDB(B1, 1, 1); PG8_SCHED; PG8_LDA(At, 1, 0); PG8_STAGE(PG8_SA(0, 1), a2 + hstep, voffA);
            PG8_WAIT_V(8); PG8_WAIT_L(0); PG8_BAR; PG8_MMA(0, 0, At, B0); PG8_MMA(0, 1, At, B1); PG8_BAR; PG8_SCHED;
            PG8_LDA(At, 1, 1); PG8_STAGE(PG8_SB(1, 0), b3, voffB); PG8_STAGE(PG8_SB(1, 1), b3 + hstep, voffB); PG8_STAGE(PG8_SA(1, 0), a3, voffA);
            PG8_WAIT_V(8); PG8_WAIT_L(0); PG8_BAR; PG8_MMA(1, 0, At, B0); PG8_MMA(1, 1, At, B1); PG8_BAR; PG8_SCHED;
            } else {
            PG8_LDB(B0, 0, 0); PG8_SCHED; PG8_LDA(At, 0, 0); PG8_STAGE(PG8_SA(1, 1), a1 + hstep, voffA);
            PG8_WAIT_L(8); PG8_BAR; PG8_WAIT_L(0); PG8_MMA(0, 0, At, B0); PG8_BAR; PG8_SCHED;
            PG8_LDB(B1, 0, 1); PG8_STAGE(PG8_SB(0, 0), b2, voffB);
            PG8_BAR; PG8_WAIT_L(0); PG8_MMA(0, 1, At, B1); PG8_BAR;
            PG8_LDA(At, 0, 1); PG8_STAGE(PG8_SA(0, 0), a2, voffA);
            PG8_BAR; PG8_WAIT_L(0); PG8_MMA(1, 0, At, B0); PG8_BAR; PG8_SCHED;
            PG8_STAGE(PG8_SB(0, 1), b2 + hstep, voffB);
            PG8_WAIT_V(6); PG8_BAR; PG8_MMA(1, 1, At, B1); PG8_BAR;
            PG8_LDB(B0, 1, 0); PG8_SCHED; PG8_LDA(At, 1, 0); PG8_STAGE(PG8_SA(0, 1), a2 + hstep, voffA);
            PG8_WAIT_L(8); PG8_BAR; PG8_WAIT_L(0); PG8_MMA(0, 0, At, B0); PG8_BAR; PG8_SCHED;
            PG8_LDB(B1, 1, 1); PG8_STAGE(PG8_SB(1, 0), b3, voffB);
            PG8_BAR; PG8_WAIT_L(0); PG8_MMA(0, 1, At, B1); PG8_BAR;
            PG8_LDA(At, 1, 1); PG8_STAGE(PG8_SA(1, 0), a3, voffA);
            PG8_BAR; PG8_WAIT_L(0); PG8_MMA(1, 0, At, B0); PG8_BAR; PG8_SCHED;
            PG8_STAGE(PG8_SB(1, 1), b3 + hstep, voffB);
            PG8_WAIT_V(6); PG8_BAR; PG8_MMA(1, 1, At, B1); PG8_BAR;
            }
        }
        if constexpr (ALIGN_EPI) { if (wr == 0) PG8_BAR; }
        if constexpr (!Epi::AFTER_DRAIN) { E(acc, cur, wr, wc, fr, fq); S.done(cur); }
        if (!has_next) break;
#pragma unroll
        for (int a = 0; a < 2; ++a)
#pragma unroll
            for (int b = 0; b < 2; ++b)
#pragma unroll
                for (int m = 0; m < 4; ++m)
#pragma unroll
                    for (int n = 0; n < 2; ++n) acc[a][b][m][n] = (f32x4){0.f, 0.f, 0.f, 0.f};
        cur = nxt; cA = nA; cB = nB; ++ui;
        if constexpr (ALIGN_EPI) { if (wr == 1) PG8_BAR; }
    }
    PG8_WAIT_V(0);
    if constexpr (!ALIGN_EPI) { if (wr == 0) PG8_BAR; }
    PG8_BAR;
    if constexpr (Epi::AFTER_DRAIN) { E.fused(acc, cur, wr, wc, fr, fq, lds, wid, lane); S.done(cur); }
#undef PG8_SA
#undef PG8_SB
#undef PG8_STAGE
#undef PG8_LDA
#undef PG8_LDB
#undef PG8_MMA
#undef PG8_WAIT_V
#undef PG8_WAIT_L
#undef PG8_BAR
#undef PG8_SCHED
}
}

constexpr int DM = 1024, NB = 4, SEQ = 4096, NMETA = 16, TT = SEQ + NMETA;
constexpr int DBATCH = 32, NPAGES = 64;
constexpr int DFF = 2816, DUP = 2 * DFF;
constexpr int MREAL = NB * SEQ;
constexpr int ROW_META = MREAL;
constexpr int ROW_SAMP = MREAL + 16;
constexpr int NROWS = MREAL + 48;
constexpr int KSTREAM = 32 + SEQ;
constexpr int NKT = KSTREAM / 32;
constexpr float LOG2E = 1.4426950408889634f;
constexpr float QSCALE = 0.125f * LOG2E;
constexpr int NWAVES = 8;

constexpr size_t MiB = 1u << 20;
constexpr size_t WS_CTL = 0, CTL_ZERO_BYTES = 1 * MiB;
constexpr size_t WS_WIN = 2 * MiB, WS_WOUT = 6 * MiB, WS_WUP = 8 * MiB, WS_WDN = 19 * MiB, WS_WPOOL = 25 * MiB;
constexpr size_t WS_QS = 26 * MiB, WS_PT = 26 * MiB + 128 * 1024, WS_ST1S = 26 * MiB + 256 * 1024, WS_ST2S = 26 * MiB + 320 * 1024, WS_PO = 27 * MiB;
constexpr size_t WS_ST1 = 28 * MiB, WS_ST2 = 30 * MiB;
constexpr size_t WS_H = 32 * MiB, WS_Q = 65 * MiB, WS_K = 82 * MiB, WS_VT = 99 * MiB, WS_U = 116 * MiB, WS_MIX = 149 * MiB;
constexpr size_t WS_X1F = 182 * MiB, WS_X1B = 247 * MiB, WS_G = 280 * MiB, WS_X2F = 369 * MiB, WS_UP = 434 * MiB, WS_END = 612 * MiB;
constexpr int CW_BAR = 4096;

constexpr size_t O_YP = 0, O_YS = O_YP + (size_t)NB * SEQ * DM, O_KP = O_YS + (size_t)DBATCH * DM, O_VP = O_KP + (size_t)NB * TT * 512, O_POOLP = O_VP + (size_t)NB * TT * 512,
                 O_CONVP = O_POOLP + (size_t)NB * 15 * 512, O_KS = O_CONVP + (size_t)NB * 2 * DUP, O_VS = O_KS + (size_t)DBATCH * 512, O_POOLS = O_VS + (size_t)DBATCH * 512,
                 O_CONVS = O_POOLS + (size_t)DBATCH * 15 * 512, O_END = O_CONVS + (size_t)DBATCH * 2 * DUP;

constexpr int RING_OFF = 0, RING_BYTES = 131072;
constexpr int LDSCTL_OFF = RING_BYTES, MISC_OFF = LDSCTL_OFF + 320;
constexpr int LDS_BYTES = 147456;

#define GAS __attribute__((address_space(1)))
#define LAS __attribute__((address_space(3)))
typedef unsigned short bf16;
typedef float f32x4 __attribute__((ext_vector_type(4)));
typedef float f32x2 __attribute__((ext_vector_type(2)));
typedef float f32x16 __attribute__((ext_vector_type(16)));
typedef short bf16x8 __attribute__((ext_vector_type(8)));
typedef unsigned u32x4 __attribute__((ext_vector_type(4)));
typedef unsigned u32x2 __attribute__((ext_vector_type(2)));
#define LDS_WAIT() asm volatile("s_waitcnt lgkmcnt(0)" ::: "memory")
using pg8::cvt_pk_bf16; using pg8::pack8; using pg8::perm16;
__device__ __forceinline__ float bf2f(unsigned short h) { return __uint_as_float((unsigned)h << 16); }
__device__ __forceinline__ unsigned short f2bf(float f) { return (unsigned short)(cvt_pk_bf16(f, 0.f) & 0xffffu); }

#define XB_TMO      128
#define XB_XCNT(j)  (256  + 64 * (j))
#define XB_XSUB(j)  (1280 + 64 * (j))
#define XB_XGEN(j)  (2304 + 64 * (j))
#define XB_TOP      3328
#define XB_TOPGEN   3392
#define XCD_BAR_WORDS 3456
#define XB_SPIN_CAP (1u << 18)

__device__ __forceinline__ unsigned xb_ld(unsigned* p)              { return __hip_atomic_load(p, __ATOMIC_RELAXED, __HIP_MEMORY_SCOPE_AGENT); }
__device__ __forceinline__ unsigned xb_add(unsigned* p, unsigned v) { return __hip_atomic_fetch_add(p, v, __ATOMIC_RELAXED, __HIP_MEMORY_SCOPE_AGENT); }
__device__ __forceinline__ unsigned xb_xcc_id() { return (unsigned)__builtin_amdgcn_s_getreg((3 << 11) | 20) & 0xFu; }
#define XB_SPIN(cond, bar) do { unsigned _sp = 0; while (cond) { __builtin_amdgcn_s_sleep(1); \
    if ((++_sp & 255u) == 0u) { if (xb_ld(&(bar)[XB_TMO])) break; if (_sp > XB_SPIN_CAP) { atomicAdd(&(bar)[XB_TMO], 1u); break; } } } } while (0)

struct XcdBarrier {
    unsigned* bar; unsigned x;
    volatile LAS unsigned* st;
};

__device__ __forceinline__ XcdBarrier xcd_barrier_post(unsigned* bar, volatile LAS unsigned* st) {
    XcdBarrier b; b.bar = bar; b.x = xb_xcc_id(); b.st = st;
    if (threadIdx.x == 0) (void)xb_add(&bar[XB_XCNT(b.x)], 1u);
    return b;
}
__device__ __forceinline__ void xcd_barrier_complete(unsigned* bar, unsigned x, unsigned& nloc, unsigned& nx) {
    const unsigned G = gridDim.x * gridDim.y * gridDim.z;
    unsigned sum, cnt, mine, sp = 0u;
    for (;;) {
        sum = 0u; cnt = 0u; mine = 0u;
#pragma unroll
        for (unsigned j = 0; j < 16; ++j) { const unsigned c = xb_ld(&bar[XB_XCNT(j)]); sum += c; cnt += (c > 0u) ? 1u : 0u; mine = (j == x) ? c : mine; }
        if (sum == G) break;
        __builtin_amdgcn_s_sleep(1);
        if ((++sp & 255u) == 0u) { if (xb_ld(&bar[XB_TMO])) break; if (sp > XB_SPIN_CAP) { atomicAdd(&bar[XB_TMO], 1u); break; } }
    }
    nloc = mine > 0u ? mine : 1u; nx = cnt > 0u ? cnt : 1u;
}

__device__ __forceinline__ void xcd_barrier(const XcdBarrier& b) {
    asm volatile("s_waitcnt vmcnt(0)" ::: "memory");
    __syncthreads();
    if (threadIdx.x == 0) {
        unsigned* bar = b.bar;
        __builtin_amdgcn_s_waitcnt(0);
        unsigned nloc = b.st[0], nx = b.st[1];
        if (nloc == 0u) { xcd_barrier_complete(bar, b.x, nloc, nx); b.st[0] = nloc; b.st[1] = nx; }
        const unsigned old = xb_add(&bar[XB_XSUB(b.x)], 1u);
        const unsigned gen = old / nloc;
        if (old + 1u == (gen + 1u) * nloc) {
            __builtin_amdgcn_fence(__ATOMIC_RELEASE, "agent");
            asm volatile("s_waitcnt vmcnt(0)" ::: "memory");
            const unsigned og = xb_add(&bar[XB_TOP], 1u);
            const unsigned tg = og / nx;
            if (og + 1u == (tg + 1u) * nx) xb_add(&bar[XB_TOPGEN], 1u);
            else XB_SPIN(xb_ld(&bar[XB_TOPGEN]) == tg, bar);
            __builtin_amdgcn_fence(__ATOMIC_ACQUIRE, "agent");
            xb_add(&bar[XB_XGEN(b.x)], 1u);
            asm volatile("s_waitcnt vmcnt(0)" ::: "memory");
        } else {
            XB_SPIN(xb_ld(&bar[XB_XGEN(b.x)]) == gen, bar);
            __builtin_amdgcn_fence(__ATOMIC_ACQUIRE, "agent");
            asm volatile("s_waitcnt vmcnt(0)" ::: "memory");
        }
    }
    __syncthreads();
}

struct Frame {
    LAS unsigned char* lds;
    volatile LAS unsigned* MISC;
    int tid, lane, wave, vcu, G;
};
__device__ __forceinline__ float wave_sum(float v) {
#pragma unroll
    for (int o = 1; o < 64; o <<= 1) v += __shfl_xor(v, o);
    return v;
}

__device__ __forceinline__ void p0_transpose_item(const float* W, int N, bf16* WT, int pitch, int out_row0, const float* kscale, const float* nscale, LAS float* scr, int k0, int n0, int lane) {
#pragma unroll 8
    for (int i = 0; i < 32; ++i) { const int kk = 2 * i + (lane >> 5), n = lane & 31; float v = W[(size_t)(k0 + kk) * N + n0 + n];
        if (kscale) v *= kscale[k0 + kk]; if (nscale) v *= nscale[n0 + n]; scr[kk * 33 + n] = v; }
    LDS_WAIT(); asm volatile("" ::: "memory");
    const int c = lane & 7;
#pragma unroll
    for (int j = 0; j < 4; ++j) { const int n = (lane >> 3) + 8 * j; const LAS float* s = scr + (8 * c) * 33 + n;
        u32x4 o; o.x = cvt_pk_bf16(s[0 * 33], s[1 * 33]); o.y = cvt_pk_bf16(s[2 * 33], s[3 * 33]); o.z = cvt_pk_bf16(s[4 * 33], s[5 * 33]); o.w = cvt_pk_bf16(s[6 * 33], s[7 * 33]);
        *(u32x4*)(WT + (size_t)(out_row0 + n) * pitch + k0 + 8 * c) = o; }
    LDS_WAIT(); asm volatile("" ::: "memory");
}
__device__ __forceinline__ void rms_row_to_bf16(const float* xrow, const float* gain, bf16* orow, int lane) {
    const f32x4* xr = (const f32x4*)xrow + lane; const f32x4* gr = (const f32x4*)gain + lane;
    f32x4 v[4]; float s = 0.f;
#pragma unroll
    for (int j = 0; j < 4; ++j) { v[j] = xr[64 * j]; s += (v[j].x * v[j].x + v[j].y * v[j].y) + (v[j].z * v[j].z + v[j].w * v[j].w); }
    const float rstd = 1.0f / sqrtf(wave_sum(s) * (1.f / 1024.f) + 1e-6f);
    u32x2* o8 = (u32x2*)orow + lane;
#pragma unroll
    for (int j = 0; j < 4; ++j) { const f32x4 g = gr[64 * j]; u32x2 w; w.x = cvt_pk_bf16(v[j].x * rstd * g.x, v[j].y * rstd * g.y); w.y = cvt_pk_bf16(v[j].z * rstd * g.z, v[j].w * rstd * g.w); o8[64 * j] = w; }
}
struct P0Args { const float *xp, *xs, *meta, *gmix, *win, *wout, *wup, *wdn, *gffn, *poolw, *pools, *spool, *sconv; bf16 *WIN, *WOUT, *WUP, *WDN, *WPOOL, *H, *Kb, *VT; float* out; };
__device__ __forceinline__ void p0_prologue(const Frame& F, const P0Args& a) {
    LAS float* scr = (LAS float*)(F.lds + RING_OFF + F.wave * 16384);
    const int gw = F.vcu * NWAVES + F.wave, NGW = F.G * NWAVES;
    constexpr int I_IN = 16 * 64, I_OUT = 16 * 32, I_UP = 16 * 176, I_DN = 44 * 32, I_POOL = 4 * 8;
    constexpr int NITEMS = I_IN + I_OUT + I_UP + I_DN + I_POOL;
    for (int it = gw; it < NITEMS; it += NGW) {
        int r = it;
        if (r < I_IN) { const int kb = r / 64, nb = r % 64; p0_transpose_item(a.win, 2048, a.WIN, 1024, 32 * nb, nullptr, nullptr, scr, 64 * kb, 32 * nb, F.lane); continue; } r -= I_IN;
        if (r < I_OUT) { const int kb = r / 32, nb = r % 32; p0_transpose_item(a.wout, 1024, a.WOUT, 1024, 32 * nb, nullptr, nullptr, scr, 64 * kb, 32 * nb, F.lane); continue; } r -= I_OUT;
        if (r < I_UP) { const int kb = r / 176, nb = r % 176; const int ch = 32 * nb, bj = ch / DFF, cc = ch % DFF;
            p0_transpose_item(a.wup, DUP, a.WUP, 1024, (cc / 128) * 256 + bj * 128 + (cc % 128), a.gffn, nullptr, scr, 64 * kb, 32 * nb, F.lane); continue; } r -= I_UP;
        if (r < I_DN) { const int kb = r / 32, nb = r % 32; p0_transpose_item(a.wdn, 1024, a.WDN, DFF, 32 * nb, nullptr, nullptr, scr, 64 * kb, 32 * nb, F.lane); continue; } r -= I_DN;
        { const int g = r / 8, q = r % 8, kb = q / 4, nb = q % 4; p0_transpose_item(a.poolw + (size_t)g * 128 * 128, 128, a.WPOOL + (size_t)g * 128 * 128, 128, 32 * nb, nullptr, a.pools + g * 128, scr, 64 * kb, 32 * nb, F.lane); }
    }
    for (int m = gw; m < NROWS; m += NGW) {
        const float* src = m < ROW_META ? a.xp + (size_t)m * DM : (m < ROW_SAMP ? a.meta + (size_t)(m - ROW_META) * DM : a.xs + (size_t)(m - ROW_SAMP) * DM);
        rms_row_to_bf16(src, a.gmix, a.H + (size_t)m * DM, F.lane);
    }
    const int gt = F.vcu * 512 + F.tid, NGT = F.G * 512;
    const u32x4 z4 = {0u, 0u, 0u, 0u};
    for (int i = gt; i < 4096; i += NGT) {
        { const int bh = i >> 7, q = i & 127; *(u32x4*)(a.Kb + (size_t)bh * KSTREAM * 64 + q * 8) = z4; }
        { const int bh = i >> 7, q = i & 127, d = q >> 1, hlf = q & 1; *(u32x4*)(a.VT + ((size_t)bh * NKT * 64 + d) * 32 + hlf * 8) = z4; }
    }
    for (int i = gt; i < DBATCH * 14 * 512; i += NGT) { const int s = i / (14 * 512), r = i % (14 * 512); a.out[O_POOLS + (size_t)s * 15 * 512 + r] = a.spool[(size_t)s * 15 * 512 + 512 + r]; }
    for (int i = gt; i < DBATCH * DUP; i += NGT) { const int s = i / DUP, c = i % DUP; a.out[O_CONVS + (size_t)s * 2 * DUP + c] = a.sconv[(size_t)s * 2 * DUP + DUP + c]; }
}

template <int NT>
__device__ __forceinline__ void small_gemm48(const Frame& F, const bf16* A, int lda, const bf16* Bt, int K, const int (&rb)[NT]) {
    const int fr = F.lane & 15, fq = F.lane >> 4;
    const int ksl = K / 8, k0 = F.wave * ksl;
    f32x4 acc[3][NT];
#pragma unroll
    for (int rt = 0; rt < 3; ++rt)
#pragma unroll
        for (int j = 0; j < NT; ++j) acc[rt][j] = (f32x4){0.f, 0.f, 0.f, 0.f};
    for (int ks = 0; ks < ksl; ks += 32) {
        const int kk = k0 + ks + 8 * fq;
        bf16x8 af[3], bfr[NT];
#pragma unroll
        for (int rt = 0; rt < 3; ++rt) af[rt] = *(const bf16x8*)(A + (size_t)(16 * rt + fr) * lda + kk);
#pragma unroll
        for (int j = 0; j < NT; ++j) bfr[j] = *(const bf16x8*)(Bt + (size_t)(rb[j] + fr) * K + kk);
#pragma unroll
        for (int rt = 0; rt < 3; ++rt)
#pragma unroll
            for (int j = 0; j < NT; ++j) acc[rt][j] = __builtin_amdgcn_mfma_f32_16x16x32_bf16(af[rt], bfr[j], acc[rt][j], 0, 0, 0);
    }
    LAS float* P = (LAS float*)(F.lds + RING_OFF);
    LAS float* T = (LAS float*)(F.lds + RING_OFF + 65536);
    constexpr int W = 16 * NT;
    __syncthreads();
#pragma unroll
    for (int rt = 0; rt < 3; ++rt)
#pragma unroll
        for (int j = 0; j < NT; ++j)
#pragma unroll
            for (int e = 0; e < 4; ++e) P[(F.wave * 48 + 16 * rt + 4 * fq + e) * W + 16 * j + fr] = acc[rt][j][e];
    __syncthreads();
    for (int idx = F.tid; idx < 48 * W; idx += 512) { float s = 0.f;
#pragma unroll
        for (int w = 0; w < 8; ++w) s += P[w * 48 * W + idx];
        T[idx] = s; }
    __syncthreads();
}

__device__ __forceinline__ bf16x8 pack8v(const f32x16& x, int s) {
    u32x4 p; p.x = cvt_pk_bf16(x[8 * s + 0], x[8 * s + 1]); p.y = cvt_pk_bf16(x[8 * s + 2], x[8 * s + 3]); p.z = cvt_pk_bf16(x[8 * s + 4], x[8 * s + 5]); p.w = cvt_pk_bf16(x[8 * s + 6], x[8 * s + 7]);
    return __builtin_bit_cast(bf16x8, p);
}
#define MFMA32(a, b, c) __builtin_amdgcn_mfma_f32_32x32x16_bf16((a), (b), (c), 0, 0, 0)
__device__ __forceinline__ void attn_block(const Frame& F, const bf16* Q, const bf16* Kb, const bf16* VT, bf16* Mix, float c0, int b, int h, int J0, int nq) {
    const int tid = F.tid, lane = F.lane, wave = F.wave;
    const int r32 = lane & 31, hi = lane >> 5;
    const int J = J0 + wave; const bool act = wave < nq;
    const int bh = b * 8 + h;
    const int pr = 32 * J + r32;
    const int qrow = (pr >= 32) ? (b * SEQ + pr - 32) : (ROW_META + (pr & 15));
    bf16x8 qf[4];
#pragma unroll
    for (int s = 0; s < 4; ++s) qf[s] = *(const bf16x8*)(Q + (size_t)(act ? qrow : 0) * 512 + h * 64 + 16 * s + 8 * hi);
    bf16x8 uf[2], ones;
#pragma unroll
    for (int ks = 0; ks < 2; ++ks)
#pragma unroll
        for (int j = 0; j < 8; ++j) uf[ks][j] = ((16 * ks + 8 * (j >> 2) + 4 * hi + (j & 3)) >= r32) ? (short)0x3F80 : (short)0;
#pragma unroll
    for (int j = 0; j < 8; ++j) ones[j] = (short)0x3F80;
    f32x16 c0v, tot, o0, o1;
#pragma unroll
    for (int i = 0; i < 16; ++i) { c0v[i] = c0; tot[i] = 0.f; o0[i] = 0.f; o1[i] = 0.f; }
    const int jtop = J0 + nq - 1;
    int ldst; const char* src;
    if (tid < 256) { const int row = tid >> 3, ch = tid & 7; ldst = row * 128 + ((ch ^ (row & 7)) << 4); src = (const char*)(Kb + (size_t)bh * KSTREAM * 64) + tid * 16; }
    else { const int t2 = tid - 256, d = t2 >> 2, ch = t2 & 3; ldst = 4096 + d * 64 + ((ch ^ ((d >> 2) & 3)) << 4); src = (const char*)(VT + (size_t)bh * NKT * 2048) + t2 * 16; }
    u32x4 stage = *(const u32x4*)(src + (size_t)jtop * 4096);
    int cur = 0;
    for (int jt = jtop; jt >= 0; --jt) {
        *(LAS u32x4*)(F.lds + RING_OFF + cur * 8192 + ldst) = stage;
        __syncthreads();
        if (jt > 0) stage = *(const u32x4*)(src + (size_t)(jt - 1) * 4096);
        if (act && jt <= J) {
            const LAS unsigned char* kb = F.lds + RING_OFF + cur * 8192;
            const LAS unsigned char* vb = kb + 4096;
            f32x16 z = c0v;
#pragma unroll
            for (int ks = 0; ks < 4; ++ks) { const bf16x8 a = *(const LAS bf16x8*)(kb + r32 * 128 + (((2 * ks + hi) ^ (r32 & 7)) << 4)); z = MFMA32(a, qf[ks], z); }
            const int lim_hi = (jt == J) ? r32 : 32, lim_lo = (jt == 0) ? 16 : 0;
            f32x16 sp;
#pragma unroll
            for (int i = 0; i < 16; ++i) { const int kr = (i & 3) + 8 * (i >> 2) + 4 * hi; const float e = __builtin_amdgcn_exp2f(z[i]); const float l = __builtin_amdgcn_logf(1.0f + e);
                sp[i] = (kr < lim_hi && kr >= lim_lo) ? l : 0.f; }
            const bf16x8 sp0 = pack8v(sp, 0), sp1 = pack8v(sp, 1);
            f32x16 cum = MFMA32(uf[0], sp0, tot); cum = MFMA32(uf[1], sp1, cum);
            tot = MFMA32(ones, sp0, tot); tot = MFMA32(ones, sp1, tot);
            f32x16 av;
#pragma unroll
            for (int i = 0; i < 16; ++i) { const int kr = (i & 3) + 8 * (i >> 2) + 4 * hi; const float p = __builtin_amdgcn_exp2f(z[i] - cum[i]); av[i] = (kr < lim_hi && kr >= lim_lo) ? p : 0.f; }
            const bf16x8 a0 = pack8v(av, 0), a1 = pack8v(av, 1);
            { const int d = r32;      const bf16x8 v0 = *(const LAS bf16x8*)(vb + d * 64 + (((0 + hi) ^ ((d >> 2) & 3)) << 4)), v1 = *(const LAS bf16x8*)(vb + d * 64 + (((2 + hi) ^ ((d >> 2) & 3)) << 4)); o0 = MFMA32(v0, a0, o0); o0 = MFMA32(v1, a1, o0); }
            { const int d = 32 + r32; const bf16x8 v0 = *(const LAS bf16x8*)(vb + d * 64 + (((0 + hi) ^ ((d >> 2) & 3)) << 4)), v1 = *(const LAS bf16x8*)(vb + d * 64 + (((2 + hi) ^ ((d >> 2) & 3)) << 4)); o1 = MFMA32(v0, a0, o1); o1 = MFMA32(v1, a1, o1); }
        }
        cur ^= 1;
    }
    if (act && (J >= 1 || (b == 0 && r32 >= 16))) {
        bf16* ob = Mix + (size_t)qrow * 1024 + h * 64;
#pragma unroll
        for (int g = 0; g < 4; ++g) {
            u32x2 w0; w0.x = cvt_pk_bf16(o0[4 * g], o0[4 * g + 1]); w0.y = cvt_pk_bf16(o0[4 * g + 2], o0[4 * g + 3]); *(u32x2*)(ob + 8 * g + 4 * hi) = w0;
            u32x2 w1; w1.x = cvt_pk_bf16(o1[4 * g], o1[4 * g + 1]); w1.y = cvt_pk_bf16(o1[4 * g + 2], o1[4 * g + 3]); *(u32x2*)(ob + 32 + 8 * g + 4 * hi) = w1;
        }
    }
    __syncthreads();
}

template <int W>
__device__ __forceinline__ void pool_rows(const float* U, int b, int t0, int col, LAS bf16* dT, int lane) {
    f32x2 ring[W]; f32x2 S = {0.f, 0.f};
#pragma unroll
    for (int i = 0; i < W; ++i) ring[i] = (f32x2){0.f, 0.f};
#pragma unroll
    for (int j = -(W - 1); j < 32; ++j) {
        const int tt = t0 + j;
        const int srow = tt >= 0 ? b * SEQ + tt : ROW_META + 16 + tt;
        const f32x2 v = *(const f32x2*)(U + (size_t)srow * 512 + col);
        const int slot = (j + W - 1) % W;
        S = S + (v - ring[slot]); ring[slot] = v;
        if (j >= 0) { const f32x2 d = S * (1.0f / W) - v; *(LAS unsigned*)(dT + j * 136 + 2 * lane) = cvt_pk_bf16(d.x, d.y); }
    }
}
__device__ __forceinline__ void pool_unit(const Frame& F, const float* U, const bf16* WPOOL, bf16* Mix, int pm, int g) {
    const int lane = F.lane, fr = lane & 15, fq = lane >> 4;
    LAS bf16* dT = (LAS bf16*)(F.lds + RING_OFF + F.wave * 8704);
    const int row0 = pm * 256 + F.wave * 32, b = row0 >> 12, t0 = row0 & 4095, col = 128 * g + 2 * lane;
    if (g == 0) pool_rows<2>(U, b, t0, col, dT, lane); else if (g == 1) pool_rows<4>(U, b, t0, col, dT, lane); else if (g == 2) pool_rows<8>(U, b, t0, col, dT, lane); else pool_rows<16>(U, b, t0, col, dT, lane);
    LDS_WAIT(); asm volatile("" ::: "memory");
    bf16x8 af[2][4];
#pragma unroll
    for (int rt = 0; rt < 2; ++rt)
#pragma unroll
        for (int ks = 0; ks < 4; ++ks) af[rt][ks] = *(const LAS bf16x8*)(dT + (16 * rt + fr) * 136 + 32 * ks + 8 * fq);
    const bf16* wp = WPOOL + (size_t)g * 128 * 128;
#pragma unroll 2
    for (int ct = 0; ct < 8; ++ct) {
        bf16x8 bfr[4];
#pragma unroll
        for (int ks = 0; ks < 4; ++ks) bfr[ks] = *(const bf16x8*)(wp + (size_t)(16 * ct + fr) * 128 + 32 * ks + 8 * fq);
#pragma unroll
        for (int rt = 0; rt < 2; ++rt) {
            f32x4 acc = {0.f, 0.f, 0.f, 0.f};
#pragma unroll
            for (int ks = 0; ks < 4; ++ks) acc = __builtin_amdgcn_mfma_f32_16x16x32_bf16(bfr[ks], af[rt][ks], acc, 0, 0, 0);
            u32x2 w; w.x = cvt_pk_bf16(acc[0], acc[1]); w.y = cvt_pk_bf16(acc[2], acc[3]);
            *(u32x2*)(Mix + (size_t)(row0 + 16 * rt + fr) * 1024 + 512 + 128 * g + 16 * ct + 4 * fq) = w;
        }
    }
    LDS_WAIT(); asm volatile("" ::: "memory");
}

template <int CTRL> __device__ __forceinline__ float dppf(float x) { return __builtin_bit_cast(float, __builtin_amdgcn_mov_dpp(__builtin_bit_cast(int, x), CTRL, 0xf, 0xf, true)); }
__device__ __forceinline__ float readlane_f(float x, int l) { return __builtin_bit_cast(float, __builtin_amdgcn_readlane(__builtin_bit_cast(int, x), l)); }
__device__ __forceinline__ float row16_sum(float x) {
    x += dppf<0xB1>(x); x += dppf<0x4E>(x); x += dppf<0x141>(x); x += dppf<0x128>(x); return x;
}
__device__ __forceinline__ void decode_item(const float* QS, const float* ck, const float* cv, const int* ptab, float* PO, float* PT, float c0, int b, int pg, int h, int lane) {
    const int c = lane & 15, g = lane >> 4;
    const f32x4 q = *(const f32x4*)(QS + b * 512 + h * 64 + 4 * c);
    float carry = 0.f; f32x4 oacc = {0.f, 0.f, 0.f, 0.f};
    for (int pi = 3; pi >= 0; --pi) {
        const int page = ptab[b * NPAGES + 4 * pg + pi];
        const size_t base = (((size_t)page * 128 + 32 * g) * 8 + h) * 64 + 4 * c;
        const float* kb = ck + base; const float* vb = cv + base;
        float S = 0.f; f32x4 acc = {0.f, 0.f, 0.f, 0.f};
#pragma unroll 8
        for (int i = 31; i >= 0; --i) {
            const f32x4 kv = __builtin_nontemporal_load((const f32x4*)(kb + i * 512));
            const f32x4 vv = __builtin_nontemporal_load((const f32x4*)(vb + i * 512));
            float d = (kv.x * q.x + kv.y * q.y) + (kv.z * q.z + kv.w * q.w);
            d = row16_sum(d);
            const float z = d + c0, e = __builtin_amdgcn_exp2f(z), sp = __builtin_amdgcn_logf(1.0f + e);
            S += sp;
            const float a = __builtin_amdgcn_exp2f(z - S);
            acc = acc + vv * a;
        }
        const float t0 = readlane_f(S, 0), t1 = readlane_f(S, 16), t2 = readlane_f(S, 32), t3 = readlane_f(S, 48);
        const float corr = carry + (g < 3 ? t3 : 0.f) + (g < 2 ? t2 : 0.f) + (g < 1 ? t1 : 0.f);
        oacc = oacc + acc * __builtin_amdgcn_exp2f(-corr);
        carry += (t0 + t1) + (t2 + t3);
    }
#pragma unroll
    for (int k = 0; k < 4; ++k) { float v = oacc[k]; v += __shfl_xor(v, 16); v += __shfl_xor(v, 32); oacc[k] = v; }
    const int it = b * 16 + pg;
    if (g == 0) *(f32x4*)(PO + ((size_t)it * 8 + h) * 64 + 4 * c) = oacc;
    if (lane == 0) PT[it * 8 + h] = carry;
}

__device__ __forceinline__ void side_pool(const Frame& F, const float* U, const float* spool, const bf16* WPOOL, bf16* Mix) {
    LAS bf16* dS = (LAS bf16*)(F.lds + RING_OFF);
    for (int idx = F.tid; idx < 48 * 256; idx += 512) {
        const int r = idx >> 8, col = 2 * (idx & 255), g = col >> 7, W = 2 << g;
        f32x2 s = {0.f, 0.f}, cur; float inv;
        if (r < 16) { const int cnt = (r + 1) < W ? (r + 1) : W; cur = *(const f32x2*)(U + (size_t)(ROW_META + r) * 512 + col);
            for (int i = 0; i < cnt; ++i) s = s + *(const f32x2*)(U + (size_t)(ROW_META + r - i) * 512 + col);
            inv = 1.0f / (float)cnt; }
        else { const int sm = r - 16; cur = *(const f32x2*)(U + (size_t)(ROW_SAMP + sm) * 512 + col); s = cur;
            for (int i = 1; i < W; ++i) s = s + *(const f32x2*)(spool + ((size_t)sm * 15 + (15 - i)) * 512 + col);
            inv = 1.0f / (float)W; }
        const f32x2 d = s * inv - cur;
        *(LAS unsigned*)(dS + r * 520 + col) = cvt_pk_bf16(d.x, d.y);
    }
    __syncthreads();
    const int fr = F.lane & 15, fq = F.lane >> 4;
    for (int p = F.wave; p < 96; p += 8) {
        const int rt = p / 32, ct = p % 32, g = ct >> 3;
        f32x4 acc = {0.f, 0.f, 0.f, 0.f};
#pragma unroll
        for (int ks = 0; ks < 4; ++ks) {
            const bf16x8 a = *(const LAS bf16x8*)(dS + (16 * rt + fr) * 520 + 128 * g + 32 * ks + 8 * fq);
            const bf16x8 bq = *(const bf16x8*)(WPOOL + ((size_t)g * 128 + 16 * (ct & 7) + fr) * 128 + 32 * ks + 8 * fq);
            acc = __builtin_amdgcn_mfma_f32_16x16x32_bf16(bq, a, acc, 0, 0, 0);
        }
        u32x2 w; w.x = cvt_pk_bf16(acc[0], acc[1]); w.y = cvt_pk_bf16(acc[2], acc[3]);
        *(u32x2*)(Mix + (size_t)(ROW_META + 16 * rt + fr) * 1024 + 512 + 16 * ct + 4 * fq) = w;
    }
    __syncthreads();
}

struct Args { const void* in[20]; float* out; unsigned char* ws; };
__device__ __forceinline__ float silu_f(float x) { return x * __builtin_amdgcn_rcpf(1.0f + __builtin_amdgcn_exp2f(-x * LOG2E)); }

__global__ void __launch_bounds__(NWAVES * 64, 2) hymba_fwd(Args args) {
    extern __shared__ __attribute__((aligned(16))) unsigned char lds[];
    Frame F;
    F.lds = (LAS unsigned char*)lds;
    F.MISC = (volatile LAS unsigned*)(F.lds + MISC_OFF);
    F.tid = threadIdx.x; F.lane = F.tid & 63; F.wave = __builtin_amdgcn_readfirstlane(F.tid >> 6);
    F.G = gridDim.x; { const int bx = blockIdx.x; F.vcu = (F.G % 8 == 0) ? (bx % 8) * (F.G / 8) + bx / 8 : bx; }
    typedef __attribute__((address_space(4))) const Args CArgs;
    CArgs* const KA = (CArgs*)__builtin_amdgcn_kernarg_segment_ptr();
#define PHASE_PTRS() CArgs* A_ = KA; asm volatile("" : "+s"(A_)); unsigned char* const ws = A_->ws; float* const out = A_->out; (void)ws; (void)out
#define INP(T, i) ((const T*)A_->in[i])
#define x_prompt INP(float, 0)
#define x_sample INP(float, 1)
#define cache_k INP(float, 2)
#define cache_v INP(float, 3)
#define state_pool INP(float, 4)
#define state_conv INP(float, 5)
#define page_table INP(int, 6)
#define meta_tokens INP(float, 7)
#define norm_mix_g INP(float, 8)
#define w_in INP(float, 9)
#define sb_bias INP(float, 10)
#define pool_w INP(float, 11)
#define pool_scale INP(float, 12)
#define w_out INP(float, 13)
#define norm_ffn_g INP(float, 14)
#define w_up INP(float, 15)
#define conv_w INP(float, 16)
#define conv_b INP(float, 17)
#define w_down INP(float, 18)
#define norm_final_g INP(float, 19)
#define WIN ((bf16*)(ws + WS_WIN))
#define WOUT ((bf16*)(ws + WS_WOUT))
#define WUP ((bf16*)(ws + WS_WUP))
#define WDN ((bf16*)(ws + WS_WDN))
#define WPOOL ((bf16*)(ws + WS_WPOOL))
#define QS ((float*)(ws + WS_QS))
#define PT ((float*)(ws + WS_PT))
#define ST1S ((float*)(ws + WS_ST1S))
#define ST2S ((float*)(ws + WS_ST2S))
#define PO ((float*)(ws + WS_PO))
#define ST1 ((float*)(ws + WS_ST1))
#define ST2 ((float*)(ws + WS_ST2))
#define Hb ((bf16*)(ws + WS_H))
#define Qb ((bf16*)(ws + WS_Q))
#define Kb ((bf16*)(ws + WS_K))
#define VT ((bf16*)(ws + WS_VT))
#define Ub ((float*)(ws + WS_U))
#define Mix ((bf16*)(ws + WS_MIX))
#define X1F ((float*)(ws + WS_X1F))
#define X1B ((bf16*)(ws + WS_X1B))
#define Gb ((bf16*)(ws + WS_G))
#define X2F ((float*)(ws + WS_X2F))
#define UPb ((bf16*)(ws + WS_UP))

    for (int u = F.tid; u < (LDS_BYTES - LDSCTL_OFF) / 4; u += NWAVES * 64) ((LAS unsigned*)(F.lds + LDSCTL_OFF))[u] = 0u;
    __syncthreads();
    XcdBarrier bar; { PHASE_PTRS(); bar = xcd_barrier_post((unsigned*)(ws + WS_CTL) + CW_BAR, F.MISC + 8); }
    LAS float* T = (LAS float*)(F.lds + RING_OFF + 65536);

    { PHASE_PTRS();
    {
        P0Args a{x_prompt, x_sample, meta_tokens, norm_mix_g, w_in, w_out, w_up, w_down, norm_ffn_g, pool_w, pool_scale, state_pool, state_conv, WIN, WOUT, WUP, WDN, WPOOL, Hb, Kb, VT, out};
        p0_prologue(F, a);
    }
    }
    xcd_barrier(bar);

    { PHASE_PTRS();
    for (int it = blockIdx.x; it < 128; it += F.G) {
        const int rb[1] = {16 * it};
        small_gemm48<1>(F, Hb + (size_t)ROW_META * DM, DM, WIN, DM, rb);
        const int kind = it >> 5;
        for (int idx = F.tid; idx < 768; idx += 512) {
            const int r = idx >> 4, c = idx & 15, cc = (16 * it + c) & 511, head = cc >> 6, d = cc & 63; const float v = T[idx];
            if (r < 16) {
                if (kind == 0) Qb[(size_t)(ROW_META + r) * 512 + cc] = f2bf(v * QSCALE);
                else if (kind == 3) Ub[(size_t)(ROW_META + r) * 512 + cc] = v;
                else {
                    const bf16 hv = f2bf(v);
#pragma unroll
                    for (int b = 0; b < NB; ++b) {
                        out[(kind == 1 ? O_KP : O_VP) + ((size_t)(b * TT + r) * 8 + head) * 64 + d] = v;
                        if (kind == 1) Kb[((size_t)(b * 8 + head) * KSTREAM + 16 + r) * 64 + d] = hv;
                        else VT[(((size_t)(b * 8 + head) * NKT + 0) * 64 + d) * 32 + 16 + perm16(r)] = hv;
                    }
                }
            } else {
                const int s = r - 16;
                if (kind == 0) QS[s * 512 + cc] = v * QSCALE;
                else if (kind == 1) out[O_KS + s * 512 + cc] = v;
                else if (kind == 2) out[O_VS + s * 512 + cc] = v;
                else { Ub[(size_t)(ROW_SAMP + s) * 512 + cc] = v; out[O_POOLS + ((size_t)s * 15 + 14) * 512 + cc] = v; }
            }
        }
    }
    __syncthreads();
    {
        pg8::Gemm g{Hb, WIN, MREAL, 2048, DM}; pg8::StaticOrder S; S.init(MREAL, 2048, F.G, (int)blockIdx.x);
        pg8::EpiIn E{Qb, Kb, VT, Ub, out + O_KP, out + O_VP, out + O_POOLP, QSCALE};
        pg8::gemm_phase<pg8::EpiIn, pg8::StaticOrder, true, true>(F.lds + RING_OFF, g, S, E);
    }
    }
    xcd_barrier(bar);

    { PHASE_PTRS();
    {
        const int st = F.vcu >> 3, p = F.vcu & 7, b = st >> 3, h = st & 7;
        const float c0 = sb_bias[h] * LOG2E;
        attn_block(F, Qb, Kb, VT, Mix, c0, b, h, 8 * (15 - p) + 1, 8);
        attn_block(F, Qb, Kb, VT, Mix, c0, b, h, 8 * p + 1, 8);
        if (p == 0 && b == 0) attn_block(F, Qb, Kb, VT, Mix, c0, b, h, 0, 1);
    }
    pool_unit(F, Ub, WPOOL, Mix, F.vcu >> 2, F.vcu & 3);
    __syncthreads();
    for (int it = F.vcu; it < 512; it += F.G)
        decode_item(QS, cache_k, cache_v, page_table, PO, PT, sb_bias[F.wave] * LOG2E, it >> 4, it & 15, F.wave, F.lane);
    }
    xcd_barrier(bar);

    { PHASE_PTRS();
    {
        const int gw = F.vcu * NWAVES + F.wave;
        if (gw < 256) { const int b = gw >> 3, h = gw & 7; float run = 0.f, o = 0.f;
            for (int pg = 15; pg >= 0; --pg) { const int it = b * 16 + pg; o += __builtin_amdgcn_exp2f(-run) * PO[((size_t)it * 8 + h) * 64 + F.lane]; run += PT[it * 8 + h]; }
            Mix[(size_t)(ROW_SAMP + b) * 1024 + h * 64 + F.lane] = f2bf(o); }
        if (F.vcu == F.G - 1) side_pool(F, Ub, state_pool, WPOOL, Mix);
    }
    }
    xcd_barrier(bar);

    { PHASE_PTRS();
    for (int it = blockIdx.x; it < 64; it += F.G) {
        const int rb[1] = {16 * it};
        small_gemm48<1>(F, Mix + (size_t)ROW_META * 1024, 1024, WOUT, DM, rb);
        for (int idx = F.tid; idx < 768; idx += 512) {
            const int r = idx >> 4, c = idx & 15, col = 16 * it + c;
            const float x = T[idx] + (r < 16 ? meta_tokens[(size_t)r * DM + col] : x_sample[(size_t)(r - 16) * DM + col]);
            X1F[(size_t)(ROW_META + r) * DM + col] = x; X1B[(size_t)(ROW_META + r) * DM + col] = f2bf(x); T[idx] = x * x;
        }
        __syncthreads();
        if (F.tid < 48) { float s = 0.f;
#pragma unroll
            for (int c = 0; c < 16; ++c) s += T[F.tid * 16 + c];
            ST1S[F.tid * 64 + it] = s; }
    }
    __syncthreads();
    {
        pg8::Gemm g{Mix, WOUT, MREAL, DM, DM}; pg8::StaticOrder S; S.init(MREAL, DM, F.G, (int)blockIdx.x);
        pg8::EpiOut E{x_prompt, X1F, X1B, ST1};
        pg8::gemm_phase<pg8::EpiOut, pg8::StaticOrder, false, true>(F.lds + RING_OFF, g, S, E);
    }
    }
    xcd_barrier(bar);

    { PHASE_PTRS();
    {
        LAS float* rr = (LAS float*)(F.lds + RING_OFF + 65536 + 8192);
        for (int it = blockIdx.x; it < 352; it += F.G) {
            const int rb[1] = {16 * it};
            small_gemm48<1>(F, X1B + (size_t)ROW_META * DM, DM, WUP, DM, rb);
            if (F.tid < 48) { float s = 0.f; for (int i = 0; i < 64; ++i) s += ST1S[F.tid * 64 + i]; rr[F.tid] = 1.0f / sqrtf(s * (1.f / 1024.f) + 1e-6f); }
            __syncthreads();
            for (int idx = F.tid; idx < 768; idx += 512) {
                const int r = idx >> 4, c = idx & 15, pc = 16 * it + c; const float v = T[idx] * rr[r];
                UPb[(size_t)(ROW_META + r) * DUP + pc] = f2bf(v);
                if (r >= 16) { const int ch = ((pc >> 7) & 1) * DFF + (pc >> 8) * 128 + (pc & 127); out[O_CONVS + ((size_t)(r - 16) * 2 + 1) * DUP + ch] = v; }
            }
        }
    }
    __syncthreads();
    {
        pg8::Gemm g{X1B, WUP, MREAL, DUP, DM}; pg8::StaticOrder S; S.init(MREAL, DUP, F.G, (int)blockIdx.x);
        pg8::EpiUpRaw E{UPb, ST1, out + O_CONVP};
        pg8::gemm_phase<pg8::EpiUpRaw, pg8::StaticOrder, true, true>(F.lds + RING_OFF, g, S, E);
    }
    }
    xcd_barrier(bar);

    { PHASE_PTRS();
    {
        const long NIT = (long)NROWS * 352;
        for (long w = (long)F.vcu * 512 + F.tid; w < NIT; w += (long)F.G * 512) {
            const int row = (int)(w / 352), c8 = (int)(w % 352), c = 8 * c8, pcg = (c >> 7) * 256 + (c & 127);
            float xg[3][8], xv[3][8];
            { const u32x4 a = *(const u32x4*)(UPb + (size_t)row * DUP + pcg), bq = *(const u32x4*)(UPb + (size_t)row * DUP + pcg + 128);
#pragma unroll
              for (int e = 0; e < 4; ++e) { xg[2][2 * e] = __uint_as_float(a[e] << 16); xg[2][2 * e + 1] = __uint_as_float(a[e] & 0xffff0000u); xv[2][2 * e] = __uint_as_float(bq[e] << 16); xv[2][2 * e + 1] = __uint_as_float(bq[e] & 0xffff0000u); } }
            if (row >= ROW_SAMP) {
                const int s = row - ROW_SAMP;
#pragma unroll
                for (int k = 0; k < 2; ++k) { const float* sg = state_conv + ((size_t)s * 2 + k) * DUP + c;
#pragma unroll
                    for (int e = 0; e < 8; ++e) { xg[k][e] = sg[e]; xv[k][e] = sg[DFF + e]; } }
            } else {
                int p1, p2;
                if (row >= ROW_META) { const int m = row - ROW_META; p1 = m >= 1 ? row - 1 : -1; p2 = m >= 2 ? row - 2 : -1; }
                else { const int t = row & 4095; p1 = t >= 1 ? row - 1 : ROW_META + 15; p2 = t >= 2 ? row - 2 : (t == 1 ? ROW_META + 15 : ROW_META + 14); }
#pragma unroll
                for (int k = 0; k < 2; ++k) { const int pr = k == 0 ? p2 : p1;
                    if (pr >= 0) { const u32x4 a = *(const u32x4*)(UPb + (size_t)pr * DUP + pcg), bq = *(const u32x4*)(UPb + (size_t)pr * DUP + pcg + 128);
#pragma unroll
                        for (int e = 0; e < 4; ++e) { xg[k][2 * e] = __uint_as_float(a[e] << 16); xg[k][2 * e + 1] = __uint_as_float(a[e] & 0xffff0000u); xv[k][2 * e] = __uint_as_float(bq[e] << 16); xv[k][2 * e + 1] = __uint_as_float(bq[e] & 0xffff0000u); } }
                    else {
#pragma unroll
                        for (int e = 0; e < 8; ++e) { xg[k][e] = 0.f; xv[k][e] = 0.f; } } }
            }
            float gg[8];
#pragma unroll
            for (int e = 0; e < 8; ++e) {
                const float cg = conv_b[c + e] + conv_w[c + e] * xg[0][e] + conv_w[DUP + c + e] * xg[1][e] + conv_w[2 * DUP + c + e] * xg[2][e];
                const float cv = conv_b[DFF + c + e] + conv_w[DFF + c + e] * xv[0][e] + conv_w[DUP + DFF + c + e] * xv[1][e] + conv_w[2 * DUP + DFF + c + e] * xv[2][e];
                gg[e] = silu_f(cg) * cv;
            }
            u32x4 o; o.x = cvt_pk_bf16(gg[0], gg[1]); o.y = cvt_pk_bf16(gg[2], gg[3]); o.z = cvt_pk_bf16(gg[4], gg[5]); o.w = cvt_pk_bf16(gg[6], gg[7]);
            *(u32x4*)(Gb + (size_t)row * DFF + c) = o;
        }
    }
    }
    xcd_barrier(bar);

    { PHASE_PTRS();
    for (int it = blockIdx.x; it < 64; it += F.G) {
        const int rb[1] = {16 * it};
        small_gemm48<1>(F, Gb + (size_t)ROW_META * DFF, DFF, WDN, DFF, rb);
        for (int idx = F.tid; idx < 768; idx += 512) {
            const int r = idx >> 4, c = idx & 15, col = 16 * it + c;
            const float x = T[idx] + X1F[(size_t)(ROW_META + r) * DM + col];
            X2F[(size_t)(ROW_META + r) * DM + col] = x; T[idx] = x * x;
        }
        __syncthreads();
        if (F.tid < 48) { float s = 0.f;
#pragma unroll
            for (int c = 0; c < 16; ++c) s += T[F.tid * 16 + c];
            ST2S[F.tid * 64 + it] = s; }
    }
    __syncthreads();
    {
        pg8::Gemm g{Gb, WDN, MREAL, DM, DFF}; pg8::StaticOrder S; S.init(MREAL, DM, F.G, (int)blockIdx.x);
        pg8::EpiDown E{X1F, X2F, ST2};
        pg8::gemm_phase<pg8::EpiDown, pg8::StaticOrder, false, true>(F.lds + RING_OFF, g, S, E);
    }
    }
    xcd_barrier(bar);

    { PHASE_PTRS();
    {
        const int gw = F.vcu * NWAVES + F.wave, NGW = F.G * NWAVES;
        for (int m = gw; m < MREAL + DBATCH; m += NGW) {
            float rs; const float* xr; float* yo;
            if (m < MREAL) { rs = pg8::row_rstd(ST2, m); xr = X2F + (size_t)m * DM; yo = out + O_YP + (size_t)m * DM; }
            else { const int s = m - MREAL; float t = ST2S[(16 + s) * 64 + F.lane]; t = wave_sum(t); rs = 1.0f / sqrtf(t * (1.f / 1024.f) + 1e-6f); xr = X2F + (size_t)(ROW_SAMP + s) * DM; yo = out + O_YS + (size_t)s * DM; }
#pragma unroll
            for (int j = 0; j < 4; ++j) { const f32x4 x = ((const f32x4*)xr)[F.lane + 64 * j], g = ((const f32x4*)norm_final_g)[F.lane + 64 * j]; ((f32x4*)yo)[F.lane + 64 * j] = x * rs * g; }
        }
    }
    }
}

extern "C" void kernel_launch(void* const* d_in, const int* in_sizes, int n_in, void* d_out, int out_size, void* d_ws, size_t ws_size, hipStream_t stream) {
    static int grid = 0;
    if (grid == 0) {
        if (n_in != 20 || ws_size < WS_END) { fprintf(stderr, "kernel_launch: unexpected shapes (n_in %d, out %d, ws %zu); nothing launched\n", n_in, out_size, ws_size); grid = -1; return; }
        int dev = 0, cus = 0, per_cu = 0;
        if (hipGetDevice(&dev) != hipSuccess || hipDeviceGetAttribute(&cus, hipDeviceAttributeMultiprocessorCount, dev) != hipSuccess) { grid = -1; return; }
        if (hipFuncSetAttribute((const void*)hymba_fwd, hipFuncAttributeMaxDynamicSharedMemorySize, LDS_BYTES) != hipSuccess) { fprintf(stderr, "kernel_launch: hipFuncSetAttribute failed\n"); grid = -1; return; }
        if (hipOccupancyMaxActiveBlocksPerMultiprocessor(&per_cu, (const void*)hymba_fwd, NWAVES * 64, LDS_BYTES) != hipSuccess || per_cu < 1)
            fprintf(stderr, "kernel_launch: note: occupancy query reports %d workgroups per CU\n", per_cu);
        (void)hipGetLastError();
        grid = cus;
        if (grid != 256) fprintf(stderr, "kernel_launch: note: %d CUs (built for 256)\n", grid);
    }
    if (grid < 0) return;
    if (hipMemsetAsync((char*)d_ws + WS_CTL, 0, CTL_ZERO_BYTES, stream) != hipSuccess) return;
    Args a{};
    for (int i = 0; i < 20; ++i) a.in[i] = d_in[i];
    a.out = (float*)d_out; a.ws = (unsigned char*)d_ws;
    hipLaunchKernelGGL(hymba_fwd, dim3(grid), dim3(NWAVES * 64), LDS_BYTES, stream, a);
}
```

```cpp
#include <hip/hip_runtime.h>
#include <stdint.h>
#include <stdio.h>
namespace pg8 {
#define PG8_LAS __attribute__((address_space(3)))
typedef unsigned short bf16_t;
typedef short bf16x8 __attribute__((ext_vector_type(8)));
typedef float f32x4 __attribute__((ext_vector_type(4)));
typedef unsigned u32x4 __attribute__((ext_vector_type(4)));
constexpr int BM = 256, BK = 64, HALF = 128, HTB = HALF * BK * 2  , STAGE_BYTES = 8 * HTB, NXCD = 8, WGM = 8;

__host__ __device__ __forceinline__ int lds_byte(int r, int c) { const int st = (r >> 4) * 2 + (c >> 5), rr = r & 15, cc = c & 31, ob = rr * 64 + cc * 2; return st * 1024 + (ob ^ (((ob >> 9) & 1) << 5)); }
__host__ __device__ __forceinline__ void stage_rc(int b, int& R, int& C) { const int st = b / 1024, sb = b % 1024, swz = sb ^ (((sb >> 9) & 1) << 5); R = (st >> 1) * 16 + swz / 64; C = (st & 1) * 32 + (swz % 64) / 2; }
__host__ __device__ __forceinline__ int perm32(int rho) { const int n = rho >> 4, i = rho & 15; return 8 * (i >> 2) + 4 * n + (i & 3); }

struct Unit { int pm, pn; };
struct Gemm { const bf16_t* A; const bf16_t* Bt; int M, N, K; };

struct StaticOrder {
    int nM, nN, nwg, G, c;
    __host__ __device__ void init(int M, int N, int G_, int c_) { nM = M / BM; nN = N / BM; nwg = nM * nN; G = G_; c = c_; }
    __host__ __device__ bool next(int i, Unit& u) const {
        const long L = (long)i * G + c; if (L >= nwg) return false;
        int wgid = (int)L; { const int q = nwg / NXCD, r = nwg % NXCD, xcd = wgid % NXCD, off = wgid / NXCD; wgid = (xcd < r ? xcd * (q + 1) : r * (q + 1) + (xcd - r) * q) + off; }
        const int nig = WGM * nN, gid = wgid / nig, fm = gid * WGM, gsz = (nM - fm) < WGM ? (nM - fm) : WGM;
        u.pm = fm + ((wgid % nig) % gsz); u.pn = (wgid % nig) / gsz; return true;
    }
    __device__ __forceinline__ void a_ready(const Unit&) const {}
    __device__ __forceinline__ void done(const Unit&) const {}
};

typedef float f32x2 __attribute__((ext_vector_type(2)));
typedef __bf16 bf16x2v __attribute__((ext_vector_type(2)));
typedef unsigned u32x2 __attribute__((ext_vector_type(2)));
__device__ __forceinline__ unsigned cvt_pk_bf16(float lo, float hi) { f32x2 v = {lo, hi}; bf16x2v b = __builtin_convertvector(v, bf16x2v); return __builtin_bit_cast(unsigned, b); }
__device__ __forceinline__ u32x4 pack8(const f32x4 a, const f32x4 b) { u32x4 w; w.x = cvt_pk_bf16(a[0], a[1]); w.y = cvt_pk_bf16(a[2], a[3]); w.z = cvt_pk_bf16(b[0], b[1]); w.w = cvt_pk_bf16(b[2], b[3]); return w; }
__device__ __forceinline__ int perm16(int x) { return (x < 4 || x >= 12) ? x : (x < 8 ? x + 4 : x - 4); }

struct EpiIn {
    static constexpr bool PERM = true, AFTER_DRAIN = false;
    bf16_t* Q; bf16_t* Kb; bf16_t* VT; float* U; float* kout; float* vout; float* poolout; float qscale;
    __device__ __forceinline__ void operator()(const f32x4 (&acc)[2][2][4][2], const Unit& u, int wr, int wc, int fr, int fq) const {
        const int kind = u.pn >> 1;
        const int ccb = (u.pn & 1) * 256 + wc * 32 + 8 * fq;
#pragma unroll
        for (int ai = 0; ai < 2; ++ai)
#pragma unroll
            for (int m = 0; m < 4; ++m) {
                const int row = u.pm * BM + ai * HALF + wr * 64 + m * 16 + fr;
                const int b = row >> 12, t = row & 4095;
#pragma unroll
                for (int bj = 0; bj < 2; ++bj) {
                    const int cc = ccb + bj * HALF;
                    const f32x4 v0 = acc[ai][bj][m][0], v1 = acc[ai][bj][m][1];
                    if (kind == 0) {
                        *(u32x4*)(Q + (size_t)row * 512 + cc) = pack8(v0 * qscale, v1 * qscale);
                    } else if (kind == 3) {
                        float* up = U + (size_t)row * 512 + cc; *(f32x4*)up = v0; *(f32x4*)(up + 4) = v1;
                        if (t >= 4081) { float* po = poolout + ((size_t)(b * 15 + (t - 4081))) * 512 + cc; *(f32x4*)po = v0; *(f32x4*)(po + 4) = v1; }
                    } else {
                        const int head = cc >> 6, d0 = cc & 63;
                        float* o = (kind == 1 ? kout : vout) + ((size_t)(b * 4112 + 16 + t) * 8 + head) * 64 + d0;
                        *(f32x4*)o = v0; *(f32x4*)(o + 4) = v1;
                        if (kind == 1) {
                            *(u32x4*)(Kb + ((size_t)(b * 8 + head) * 4128 + 32 + t) * 64 + d0) = pack8(v0, v1);
                        } else {
                            const int J = 1 + (t >> 5), kl = t & 31, pos = (kl & 16) | perm16(kl & 15);
                            bf16_t* vp = VT + (((size_t)(b * 8 + head) * 129 + J) * 64 + d0) * 32 + pos;
                            const u32x4 w = pack8(v0, v1);
                            vp[0 * 32] = (bf16_t)(w.x & 0xffffu); vp[1 * 32] = (bf16_t)(w.x >> 16); vp[2 * 32] = (bf16_t)(w.y & 0xffffu); vp[3 * 32] = (bf16_t)(w.y >> 16);
                            vp[4 * 32] = (bf16_t)(w.z & 0xffffu); vp[5 * 32] = (bf16_t)(w.z >> 16); vp[6 * 32] = (bf16_t)(w.w & 0xffffu); vp[7 * 32] = (bf16_t)(w.w >> 16);
                        }
                    }
                }
            }
    }
};

struct EpiOut {
    static constexpr bool PERM = false, AFTER_DRAIN = false;
    const float* xres; float* x1f; bf16_t* x1b; float* stat;
    __device__ __forceinline__ void operator()(const f32x4 (&acc)[2][2][4][2], const Unit& u, int wr, int wc, int fr, int fq) const {
#pragma unroll
        for (int ai = 0; ai < 2; ++ai)
#pragma unroll
            for (int m = 0; m < 4; ++m) {
                const int row = u.pm * BM + ai * HALF + wr * 64 + m * 16 + fr;
                float ss = 0.f;
#pragma unroll
                for (int bj = 0; bj < 2; ++bj)
#pragma unroll
                    for (int n = 0; n < 2; ++n) {
                        const int col = u.pn * BM + bj * HALF + wc * 32 + n * 16 + 4 * fq;
                        const size_t off = (size_t)row * 1024 + col;
                        const f32x4 x = acc[ai][bj][m][n] + *(const f32x4*)(xres + off);
                        *(f32x4*)(x1f + off) = x;
                        u32x2 w; w.x = cvt_pk_bf16(x[0], x[1]); w.y = cvt_pk_bf16(x[2], x[3]);
                        *(u32x2*)(x1b + off) = w;
                        ss += (x[0] * x[0] + x[1] * x[1]) + (x[2] * x[2] + x[3] * x[3]);
                    }
                ss += __shfl_xor(ss, 16); ss += __shfl_xor(ss, 32);
                if (fq == 0) stat[(size_t)row * 16 + u.pn * 4 + wc] = ss;
            }
    }
};

__device__ __forceinline__ float row_rstd(const float* stat, int row) {
    const f32x4 a = *(const f32x4*)(stat + (size_t)row * 16), b = *(const f32x4*)(stat + (size_t)row * 16 + 4), c = *(const f32x4*)(stat + (size_t)row * 16 + 8), d = *(const f32x4*)(stat + (size_t)row * 16 + 12);
    const float s = (((a[0] + a[1]) + (a[2] + a[3])) + ((b[0] + b[1]) + (b[2] + b[3]))) + (((c[0] + c[1]) + (c[2] + c[3])) + ((d[0] + d[1]) + (d[2] + d[3])));
    return 1.0f / sqrtf(s * (1.0f / 1024.0f) + 1e-6f);
}

template <int CTRL> __device__ __forceinline__ float dpp_mov(float x) { return __builtin_bit_cast(float, __builtin_amdgcn_update_dpp(0, __builtin_bit_cast(int, x), CTRL, 0xf, 0xf, true)); }
template <int CTRL> __device__ __forceinline__ float dpp_upd(float old, float x) { return __builtin_bit_cast(float, __builtin_amdgcn_update_dpp(__builtin_bit_cast(int, old), __builtin_bit_cast(int, x), CTRL, 0xf, 0xf, false)); }
__device__ __forceinline__ float silu_f(float x) { return x * __builtin_amdgcn_rcpf(1.0f + __builtin_amdgcn_exp2f(-1.4426950408889634f * x)); }
struct EpiUpConv {
    static constexpr bool PERM = true, AFTER_DRAIN = false;
    bf16_t* G; const float* stat; float* convp; const float* cw; const float* cb; float* FB; float* HB; PG8_LAS float* X;
    __device__ __forceinline__ void operator()(const f32x4 (&acc)[2][2][4][2], const Unit& u, int wr, int wc, int fr, int fq) const {
        const int cl = wc * 32 + 8 * fq;
        PG8_LAS float* RS2 = X + 2048;
        { const int tid = (wr * 4 + wc) * 64 + fq * 16 + fr, r = tid & 255, hf = tid >> 8;
          const f32x4 a = *(const f32x4*)(stat + (size_t)(u.pm * BM + r) * 16 + 8 * hf), b = *(const f32x4*)(stat + (size_t)(u.pm * BM + r) * 16 + 8 * hf + 4);
          RS2[hf * 256 + r] = ((a[0] + a[1]) + (a[2] + a[3])) + ((b[0] + b[1]) + (b[2] + b[3])); }
        if (fr >= 14) {
#pragma unroll
            for (int ai = 0; ai < 2; ++ai)
#pragma unroll
                for (int bj = 0; bj < 2; ++bj)
#pragma unroll
                    for (int n = 0; n < 2; ++n) *(PG8_LAS f32x4*)(X + ((2 * ai + wr) * 2 + (fr - 14)) * 256 + bj * HALF + cl + 4 * n) = acc[ai][bj][3][n];
        }
        asm volatile("s_waitcnt lgkmcnt(0)" ::: "memory"); __builtin_amdgcn_s_barrier(); asm volatile("" ::: "memory");
        float rs[2][4];
#pragma unroll
        for (int ai = 0; ai < 2; ++ai)
#pragma unroll
            for (int m = 0; m < 4; ++m) { const int r = ai * HALF + wr * 64 + m * 16 + fr; rs[ai][m] = 1.0f / sqrtf((RS2[r] + RS2[256 + r]) * (1.0f / 1024.0f) + 1e-6f); }
        if (fr >= 14 && wr == 1) {
#pragma unroll
            for (int bj = 0; bj < 2; ++bj)
#pragma unroll
                for (int n = 0; n < 2; ++n) {
                    const f32x4 v = acc[1][bj][3][n] * rs[1][3];
                    *(f32x4*)(HB + ((size_t)u.pm * 2 + (fr - 14)) * 5632 + u.pn * BM + bj * HALF + cl + 4 * n) = v;
                    if ((u.pm & 15) == 15) *(f32x4*)(convp + ((size_t)(u.pm >> 4) * 2 + (fr - 14)) * 5632 + bj * 2816 + u.pn * 128 + cl + 4 * n) = v;
                }
        }
        if (fr < 2 && wr == 0) {
#pragma unroll
            for (int bj = 0; bj < 2; ++bj)
#pragma unroll
                for (int n = 0; n < 2; ++n) *(f32x4*)(FB + ((size_t)u.pm * 2 + fr) * 5632 + u.pn * BM + bj * HALF + cl + 4 * n) = acc[0][bj][0][n] * rs[0][0];
        }
        asm volatile("" ::: "memory");
#pragma unroll
        for (int n = 0; n < 2; ++n) {
            const int chg = u.pn * 128 + cl + 4 * n;
            const f32x4 bg = *(const f32x4*)(cb + chg), bv = *(const f32x4*)(cb + 2816 + chg);
            const f32x4 g0 = *(const f32x4*)(cw + chg), g1 = *(const f32x4*)(cw + 5632 + chg), g2 = *(const f32x4*)(cw + 2 * 5632 + chg);
            const f32x4 v0 = *(const f32x4*)(cw + 2816 + chg), v1 = *(const f32x4*)(cw + 5632 + 2816 + chg), v2 = *(const f32x4*)(cw + 2 * 5632 + 2816 + chg);
#pragma unroll
            for (int ai = 0; ai < 2; ++ai) {
                const int ch = 2 * ai + wr;
                f32x4 pg = {0.f, 0.f, 0.f, 0.f}, pv = {0.f, 0.f, 0.f, 0.f};
                if (ch > 0 && fr >= 14) { const float rp = 1.0f / sqrtf((RS2[64 * ch - 16 + fr] + RS2[256 + 64 * ch - 16 + fr]) * (1.0f / 1024.0f) + 1e-6f);
                    pg = *(const PG8_LAS f32x4*)(X + ((ch - 1) * 2 + (fr - 14)) * 256 + cl + 4 * n) * rp; pv = *(const PG8_LAS f32x4*)(X + ((ch - 1) * 2 + (fr - 14)) * 256 + HALF + cl + 4 * n) * rp; }
#pragma unroll
                for (int m = 0; m < 4; ++m) {
                    const f32x4 xg = acc[ai][0][m][n] * rs[ai][m], xv = acc[ai][1][m][n] * rs[ai][m];
                    float go[4];
#pragma unroll
                    for (int e = 0; e < 4; ++e) {
                        const float g1p = dpp_upd<0x111>(dpp_mov<0x121>(pg[e]), xg[e]), g2p = dpp_upd<0x112>(dpp_mov<0x122>(pg[e]), xg[e]);
                        const float v1p = dpp_upd<0x111>(dpp_mov<0x121>(pv[e]), xv[e]), v2p = dpp_upd<0x112>(dpp_mov<0x122>(pv[e]), xv[e]);
                        const float cg = bg[e] + g0[e] * g2p + g1[e] * g1p + g2[e] * xg[e];
                        const float cv = bv[e] + v0[e] * v2p + v1[e] * v1p + v2[e] * xv[e];
                        go[e] = silu_f(cg) * cv;
                    }
                    u32x2 w; w.x = cvt_pk_bf16(go[0], go[1]); w.y = cvt_pk_bf16(go[2], go[3]);
                    *(u32x2*)(G + (size_t)(u.pm * BM + ai * HALF + wr * 64 + m * 16 + fr) * 2816 + chg) = w;
                    pg = xg; pv = xv;
                    asm volatile("" ::: "memory");
                }
            }
            asm volatile("" ::: "memory");
        }
    }
};

struct EpiDown {
    static constexpr bool PERM = false, AFTER_DRAIN = false;
    const float* x1f; float* x2f; float* stat;
    __device__ __forceinline__ void operator()(const f32x4 (&acc)[2][2][4][2], const Unit& u, int wr, int wc, int fr, int fq) const {
#pragma unroll
        for (int ai = 0; ai < 2; ++ai)
#pragma unroll
            for (int m = 0; m < 4; ++m) {
                const int row = u.pm * BM + ai * HALF + wr * 64 + m * 16 + fr;
                float ss = 0.f;
#pragma unroll
                for (int bj = 0; bj < 2; ++bj)
#pragma unroll
                    for (int n = 0; n < 2; ++n) {
                        const int col = u.pn * BM + bj * HALF + wc * 32 + n * 16 + 4 * fq;
                        const size_t off = (size_t)row * 1024 + col;
                        const f32x4 x = acc[ai][bj][m][n] + *(const f32x4*)(x1f + off);
                        *(f32x4*)(x2f + off) = x;
                        ss += (x[0] * x[0] + x[1] * x[1]) + (x[2] * x[2] + x[3] * x[3]);
                    }
                ss += __shfl_xor(ss, 16); ss += __shfl_xor(ss, 32);
                if (fq == 0) stat[(size_t)row * 16 + u.pn * 4 + wc] = ss;
            }
    }
};

template <class Epi, class Sched, bool ALIGN_EPI = false, bool SP2 = false>
__device__ __forceinline__ void gemm_phase(PG8_LAS unsigned char* lds, const Gemm g, const Sched& S, const Epi& E) {
    int tid_ = threadIdx.x; asm volatile("" : "+v"(tid_));
    const int tid = tid_, wid = __builtin_amdgcn_readfirstlane(tid >> 6), lane = tid & 63, wr = wid >> 2, wc = wid & 3, fr = lane & 15, fq = lane >> 4;
    const int K = g.K, nt = K / BK;
    unsigned voffA[2], voffB[2];
#pragma unroll
    for (int i = 0; i < 2; ++i) { int R, C; stage_rc(tid * 16 + i * 8192, R, C); const int Rb = Epi::PERM ? ((R & ~31) + perm32(R & 31)) : R;
        voffA[i] = (unsigned)(R * K + C) * 2u; voffB[i] = (unsigned)(Rb * K + C) * 2u; }
    const size_t kstep = (size_t)(BK * 2);
    const size_t hstep = (size_t)HALF * K * 2;
    const size_t tstep = 2 * hstep;
    const unsigned ldsw = (unsigned)wid * 1024u;
    const int aoff = lds_byte(wr * 64 + fr, fq * 8), boff = lds_byte(wc * 32 + fr, fq * 8);
#define PG8_SA(b, h) (((b) * 2 + (h)) * HTB)
#define PG8_SB(b, h) ((4 + (b) * 2 + (h)) * HTB)
#define PG8_STAGE(bufoff, gbase, voff) do { _Pragma("unroll") for (int _i = 0; _i < 2; ++_i) \
        __builtin_amdgcn_global_load_lds((const unsigned*)((const char*)(gbase) + (voff)[_i]), (PG8_LAS unsigned*)(lds + (bufoff) + ldsw + _i * 8192), 16, 0, 0); } while (0)
#define PG8_LDA(dst, b, h) do { _Pragma("unroll") for (int m = 0; m < 4; ++m) _Pragma("unroll") for (int k = 0; k < 2; ++k) dst[m][k] = *(const PG8_LAS bf16x8*)(lds + PG8_SA(b, h) + aoff + m * 2048 + k * 1024); } while (0)
#define PG8_LDB(dst, b, h) do { _Pragma("unroll") for (int n = 0; n < 2; ++n) _Pragma("unroll") for (int k = 0; k < 2; ++k) dst[n][k] = *(const PG8_LAS bf16x8*)(lds + PG8_SB(b, h) + boff + n * 2048 + k * 1024); } while (0)
#define PG8_MMA(ai, bj, At, Bt) do { __builtin_amdgcn_s_setprio(1); _Pragma("unroll") for (int m = 0; m < 4; ++m) _Pragma("unroll") for (int n = 0; n < 2; ++n) _Pragma("unroll") for (int k = 0; k < 2; ++k) \
        acc[ai][bj][m][n] = __builtin_amdgcn_mfma_f32_16x16x32_bf16(Bt[n][k], At[m][k], acc[ai][bj][m][n], 0, 0, 0); __builtin_amdgcn_s_setprio(0); } while (0)
#define PG8_WAIT_V(n) asm volatile("s_waitcnt vmcnt(" #n ")" ::: "memory")
#define PG8_WAIT_L(n) asm volatile("s_waitcnt lgkmcnt(" #n ")" ::: "memory")
#define PG8_BAR __builtin_amdgcn_s_barrier()
#define PG8_SCHED __builtin_amdgcn_sched_barrier(0)
    Unit cur, nxt; int ui = 0;
    if (!S.next(0, cur)) return;
    f32x4 acc[2][2][4][2];
#pragma unroll
    for (int a = 0; a < 2; ++a)
#pragma unroll
        for (int b = 0; b < 2; ++b)
#pragma unroll
            for (int m = 0; m < 4; ++m)
#pragma unroll
                for (int n = 0; n < 2; ++n) acc[a][b][m][n] = (f32x4){0.f, 0.f, 0.f, 0.f};
    bf16x8 At[4][2], B0[2][2], B1[2][2];
    const char* cA = (const char*)g.A + (size_t)cur.pm * tstep; const char* cB = (const char*)g.Bt + (size_t)cur.pn * tstep;
    S.a_ready(cur);
    if constexpr (SP2) {
        PG8_STAGE(PG8_SB(0, 0), cB, voffB); PG8_STAGE(PG8_SB(0, 1), cB + hstep, voffB); PG8_STAGE(PG8_SA(0, 0), cA, voffA); PG8_STAGE(PG8_SA(0, 1), cA + hstep, voffA);
        if (wr == 1) PG8_BAR;
        PG8_WAIT_V(2); PG8_BAR;
        PG8_STAGE(PG8_SB(1, 0), cB + kstep, voffB); PG8_STAGE(PG8_SA(1, 0), cA + kstep, voffA); PG8_STAGE(PG8_SB(1, 1), cB + hstep + kstep, voffB);
        PG8_WAIT_V(6); PG8_BAR;
    } else {
        PG8_STAGE(PG8_SB(0, 0), cB, voffB); PG8_STAGE(PG8_SA(0, 0), cA, voffA); PG8_STAGE(PG8_SB(0, 1), cB + hstep, voffB); PG8_STAGE(PG8_SA(0, 1), cA + hstep, voffA);
        if (wr == 1) PG8_BAR;
        PG8_WAIT_V(4); PG8_BAR;
        PG8_STAGE(PG8_SB(1, 0), cB + kstep, voffB); PG8_STAGE(PG8_SA(1, 0), cA + kstep, voffA); PG8_STAGE(PG8_SB(1, 1), cB + hstep + kstep, voffB);
        PG8_WAIT_V(6); PG8_BAR;
    }
    for (;;) {
        const bool has_next = S.next(ui + 1, nxt);
        const char* nA = has_next ? (const char*)g.A + (size_t)nxt.pm * tstep : cA; const char* nB = has_next ? (const char*)g.Bt + (size_t)nxt.pn * tstep : cB;
        for (int t = 0; t < nt; t += 2) {
            const bool last = (t == nt - 2);
            const char* a1 = cA + (size_t)(t + 1) * kstep;
            const char* a2 = last ? nA : cA + (size_t)(t + 2) * kstep; const char* b2 = last ? nB : cB + (size_t)(t + 2) * kstep;
            const char* a3 = a2 + kstep; const char* b3 = b2 + kstep;
            if (last && has_next) S.a_ready(nxt);
            if constexpr (SP2) {
            PG8_LDB(B0, 0, 0); PG8_LDB(B1, 0, 1); PG8_SCHED; PG8_LDA(At, 0, 0); PG8_STAGE(PG8_SA(1, 1), a1 + hstep, voffA);
            PG8_WAIT_V(8); PG8_WAIT_L(0); PG8_BAR; PG8_MMA(0, 0, At, B0); PG8_MMA(0, 1, At, B1); PG8_BAR; PG8_SCHED;
            PG8_LDA(At, 0, 1); PG8_STAGE(PG8_SB(0, 0), b2, voffB); PG8_STAGE(PG8_SB(0, 1), b2 + hstep, voffB); PG8_STAGE(PG8_SA(0, 0), a2, voffA);
            PG8_WAIT_V(8); PG8_WAIT_L(0); PG8_BAR; PG8_MMA(1, 0, At, B0); PG8_MMA(1, 1, At, B1); PG8_BAR; PG8_SCHED;
            PG8_LDB(B0, 1, 0); PG8_LDB(B1, 1, 1); PG8_SCHED; PG8_LDA(At, 1, 0); PG8_STAGE(PG8_SA(0, 1), a2 + hstep, voffA);
            PG8_WAIT_V(8); PG8_WAIT_L(0); PG8_BAR; PG8_MMA(0, 0, At, B0); PG8_MMA(0, 1, At, B1); PG8_BAR; PG8_SCHED;
            PG8_LDA(At, 1, 1); PG8_STAGE(PG8_SB(1, 0), b3, voffB); PG8_STAGE(PG8_SB(1, 1), b3 + hstep, voffB); PG8_STAGE(PG8_SA(1, 0), a3, voffA);
            PG8_WAIT_V(8); PG8_WAIT_L(0); PG8_BAR; PG8_MMA(1, 0, At, B0); PG8_MMA(1, 1, At, B1); PG8_BAR; PG8_SCHED;
            } else {
            PG8_LDB(B0, 0, 0); PG8_SCHED; PG8_LDA(At, 0, 0); PG8_STAGE(PG8_SA(1, 1), a1 + hstep, voffA);
            PG8_WAIT_L(8); PG8_BAR; PG8_WAIT_L(0); PG8_MMA(0, 0, At, B0); PG8_BAR; PG8_SCHED;
            PG8_LDB(B1, 0, 1); PG8_STAGE(PG8_SB(0, 0), b2, voffB);
            PG8_BAR; PG8_WAIT_L(0); PG8_MMA(0, 1, At, B1); PG8_BAR;
            PG8_LDA(At, 0, 1); PG8_STAGE(PG8_SA(0, 0), a2, voffA);
            PG8_BAR; PG8_WAIT_L(0); PG8_MMA(1, 0, At, B0); PG8_BAR; PG8_SCHED;
            PG8_STAGE(PG8_SB(0, 1), b2 + hstep, voffB);
            PG8_WAIT_V(6); PG8_BAR; PG8_MMA(1, 1, At, B1); PG8_BAR;
            PG8_LDB(B0, 1, 0); PG8_SCHED; PG8_LDA(At, 1, 0); PG8_STAGE(PG8_SA(0, 1), a2 + hstep, voffA);
            PG8_WAIT_L(8); PG8_BAR; PG8_WAIT_L(0); PG8_MMA(0, 0, At, B0); PG8_BAR; PG8_SCHED;
            PG8_LDB(B1, 1, 1); PG8_STAGE(PG8_SB(1, 0), b3, voffB);
            PG8_BAR; PG8_WAIT_L(0); PG8_MMA(0, 1, At, B1); PG8_BAR;
            PG8_LDA(At, 1, 1); PG8_STAGE(PG8_SA(1, 0), a3, voffA);
            PG8_BAR; PG8_WAIT_L(0); PG8_MMA(1, 0, At, B0); PG8_BAR; PG8_SCHED;
            PG8_STAGE(PG8_SB(1, 1), b3 + hstep, voffB);
            PG8_WAIT_V(6); PG8_BAR; PG8_MMA(1, 1, At, B1); PG8_BAR;
            }
        }
        if constexpr (ALIGN_EPI) { if (wr == 0) PG8_BAR; }
        if constexpr (!Epi::AFTER_DRAIN) { E(acc, cur, wr, wc, fr, fq); S.done(cur); }
        if (!has_next) break;
#pragma unroll
        for (int a = 0; a < 2; ++a)
#pragma unroll
            for (int b = 0; b < 2; ++b)
#pragma unroll
                for (int m = 0; m < 4; ++m)
#pragma unroll
                    for (int n = 0; n < 2; ++n) acc[a][b][m][n] = (f32x4){0.f, 0.f, 0.f, 0.f};
        cur = nxt; cA = nA; cB = nB; ++ui;
        if constexpr (ALIGN_EPI) { if (wr == 1) PG8_BAR; }
    }
    PG8_WAIT_V(0);
    if constexpr (!ALIGN_EPI) { if (wr == 0) PG8_BAR; }
    PG8_BAR;
    if constexpr (Epi::AFTER_DRAIN) { E.fused(acc, cur, wr, wc, fr, fq, lds, wid, lane); S.done(cur); }
#undef PG8_SA
#undef PG8_SB
#undef PG8_STAGE
#undef PG8_LDA
#undef PG8_LDB
#undef PG8_MMA
#undef PG8_WAIT_V
#undef PG8_WAIT_L
#undef PG8_BAR
#undef PG8_SCHED
}
}

constexpr int DM = 1024, NB = 4, SEQ = 4096, NMETA = 16, TT = SEQ + NMETA;
constexpr int DBATCH = 32, NPAGES = 64;
constexpr int DFF = 2816, DUP = 2 * DFF;
constexpr int MREAL = NB * SEQ;
constexpr int ROW_META = MREAL;
constexpr int ROW_SAMP = MREAL + 16;
constexpr int NROWS = MREAL + 48;
constexpr int KSTREAM = 32 + SEQ;
constexpr int NKT = KSTREAM / 32;
constexpr float LOG2E = 1.4426950408889634f;
constexpr float QSCALE = 0.125f * LOG2E;
constexpr int NWAVES = 8;

constexpr size_t MiB = 1u << 20;
constexpr size_t WS_CTL = 0, CTL_ZERO_BYTES = 1 * MiB;
constexpr size_t WS_WIN = 2 * MiB, WS_WOUT = 6 * MiB, WS_WUP = 8 * MiB, WS_WDN = 19 * MiB, WS_WPOOL = 25 * MiB;
constexpr size_t WS_QS = 26 * MiB, WS_PT = 26 * MiB + 128 * 1024, WS_ST1S = 26 * MiB + 256 * 1024, WS_ST2S = 26 * MiB + 320 * 1024, WS_PO = 27 * MiB;
constexpr size_t WS_ST1 = 28 * MiB, WS_ST2 = 30 * MiB;
constexpr size_t WS_H = 32 * MiB, WS_Q = 65 * MiB, WS_K = 82 * MiB, WS_VT = 99 * MiB, WS_U = 116 * MiB, WS_MIX = 149 * MiB;
constexpr size_t WS_X1F = 182 * MiB, WS_X1B = 247 * MiB, WS_G = 280 * MiB, WS_X2F = 369 * MiB, WS_FB = 434 * MiB, WS_HB = 438 * MiB, WS_HM = 442 * MiB, WS_END = 443 * MiB;
constexpr int CW_BAR = 4096;

constexpr size_t O_YP = 0, O_YS = O_YP + (size_t)NB * SEQ * DM, O_KP = O_YS + (size_t)DBATCH * DM, O_VP = O_KP + (size_t)NB * TT * 512, O_POOLP = O_VP + (size_t)NB * TT * 512,
                 O_CONVP = O_POOLP + (size_t)NB * 15 * 512, O_KS = O_CONVP + (size_t)NB * 2 * DUP, O_VS = O_KS + (size_t)DBATCH * 512, O_POOLS = O_VS + (size_t)DBATCH * 512,
                 O_CONVS = O_POOLS + (size_t)DBATCH * 15 * 512, O_END = O_CONVS + (size_t)DBATCH * 2 * DUP;

constexpr int RING_OFF = 0, RING_BYTES = 131072;
constexpr int LDSCTL_OFF = RING_BYTES, MISC_OFF = LDSCTL_OFF + 320;
constexpr int XCH_OFF = RING_BYTES + 1024;
constexpr int LDS_BYTES = 147456;

#define GAS __attribute__((address_space(1)))
#define LAS __attribute__((address_space(3)))
typedef unsigned short bf16;
typedef float f32x4 __attribute__((ext_vector_type(4)));
typedef float f32x2 __attribute__((ext_vector_type(2)));
typedef float f32x16 __attribute__((ext_vector_type(16)));
typedef short bf16x8 __attribute__((ext_vector_type(8)));
typedef unsigned u32x4 __attribute__((ext_vector_type(4)));
typedef unsigned u32x2 __attribute__((ext_vector_type(2)));
#define LDS_WAIT() asm volatile("s_waitcnt lgkmcnt(0)" ::: "memory")
using pg8::cvt_pk_bf16; using pg8::pack8; using pg8::perm16;
__device__ __forceinline__ float bf2f(unsigned short h) { return __uint_as_float((unsigned)h << 16); }
__device__ __forceinline__ unsigned short f2bf(float f) { return (unsigned short)(cvt_pk_bf16(f, 0.f) & 0xffffu); }

#define XB_TMO      128
#define XB_XCNT(j)  (256  + 64 * (j))
#define XB_XSUB(j)  (1280 + 64 * (j))
#define XB_XGEN(j)  (2304 + 64 * (j))
#define XB_TOP      3328
#define XB_TOPGEN   3392
#define XCD_BAR_WORDS 3456
#define XB_SPIN_CAP (1u << 18)

__device__ __forceinline__ unsigned xb_ld(unsigned* p)              { return __hip_atomic_load(p, __ATOMIC_RELAXED, __HIP_MEMORY_SCOPE_AGENT); }
__device__ __forceinline__ unsigned xb_add(unsigned* p, unsigned v) { return __hip_atomic_fetch_add(p, v, __ATOMIC_RELAXED, __HIP_MEMORY_SCOPE_AGENT); }
__device__ __forceinline__ unsigned xb_xcc_id() { return (unsigned)__builtin_amdgcn_s_getreg((3 << 11) | 20) & 0xFu; }
#define XB_SPIN(cond, bar) do { unsigned _sp = 0; while (cond) { __builtin_amdgcn_s_sleep(1); \
    if ((++_sp & 255u) == 0u) { if (xb_ld(&(bar)[XB_TMO])) break; if (_sp > XB_SPIN_CAP) { atomicAdd(&(bar)[XB_TMO], 1u); break; } } } } while (0)

struct XcdBarrier {
    unsigned* bar; unsigned x;
    volatile LAS unsigned* st;
};

__device__ __forceinline__ XcdBarrier xcd_barrier_post(unsigned* bar, volatile LAS unsigned* st) {
    XcdBarrier b; b.bar = bar; b.x = xb_xcc_id(); b.st = st;
    if (threadIdx.x == 0) (void)xb_add(&bar[XB_XCNT(b.x)], 1u);
    return b;
}
__device__ __forceinline__ void xcd_barrier_complete(unsigned* bar, unsigned x, unsigned& nloc, unsigned& nx) {
    const unsigned G = gridDim.x * gridDim.y * gridDim.z;
    unsigned sum, cnt, mine, sp = 0u;
    for (;;) {
        sum = 0u; cnt = 0u; mine = 0u;
#pragma unroll
        for (unsigned j = 0; j < 16; ++j) { const unsigned c = xb_ld(&bar[XB_XCNT(j)]); sum += c; cnt += (c > 0u) ? 1u : 0u; mine = (j == x) ? c : mine; }
        if (sum == G) break;
        __builtin_amdgcn_s_sleep(1);
        if ((++sp & 255u) == 0u) { if (xb_ld(&bar[XB_TMO])) break; if (sp > XB_SPIN_CAP) { atomicAdd(&bar[XB_TMO], 1u); break; } }
    }
    nloc = mine > 0u ? mine : 1u; nx = cnt > 0u ? cnt : 1u;
}

__device__ __forceinline__ void xcd_barrier(const XcdBarrier& b) {
    asm volatile("s_waitcnt vmcnt(0)" ::: "memory");
    __syncthreads();
    if (threadIdx.x == 0) {
        unsigned* bar = b.bar;
        __builtin_amdgcn_s_waitcnt(0);
        unsigned nloc = b.st[0], nx = b.st[1];
        if (nloc == 0u) { xcd_barrier_complete(bar, b.x, nloc, nx); b.st[0] = nloc; b.st[1] = nx; }
        const unsigned old = xb_add(&bar[XB_XSUB(b.x)], 1u);
        const unsigned gen = old / nloc;
        if (old + 1u == (gen + 1u) * nloc) {
            __builtin_amdgcn_fence(__ATOMIC_RELEASE, "agent");
            asm volatile("s_waitcnt vmcnt(0)" ::: "memory");
            const unsigned og = xb_add(&bar[XB_TOP], 1u);
            const unsigned tg = og / nx;
            if (og + 1u == (tg + 1u) * nx) xb_add(&bar[XB_TOPGEN], 1u);
            else XB_SPIN(xb_ld(&bar[XB_TOPGEN]) == tg, bar);
            __builtin_amdgcn_fence(__ATOMIC_ACQUIRE, "agent");
            xb_add(&bar[XB_XGEN(b.x)], 1u);
            asm volatile("s_waitcnt vmcnt(0)" ::: "memory");
        } else {
            XB_SPIN(xb_ld(&bar[XB_XGEN(b.x)]) == gen, bar);
            __builtin_amdgcn_fence(__ATOMIC_ACQUIRE, "agent");
            asm volatile("s_waitcnt vmcnt(0)" ::: "memory");
        }
    }
    __syncthreads();
}

struct Frame {
    LAS unsigned char* lds;
    volatile LAS unsigned* MISC;
    int tid, lane, wave, vcu, G;
};
__device__ __forceinline__ float wave_sum(float v) {
#pragma unroll
    for (int o = 1; o < 64; o <<= 1) v += __shfl_xor(v, o);
    return v;
}

__device__ __forceinline__ void p0_transpose_item(const float* W, int N, bf16* WT, int pitch, int out_row0, const float* kscale, const float* nscale, LAS float* scr, int k0, int n0, int lane) {
#pragma unroll 8
    for (int i = 0; i < 32; ++i) { const int kk = 2 * i + (lane >> 5), n = lane & 31; float v = W[(size_t)(k0 + kk) * N + n0 + n];
        if (kscale) v *= kscale[k0 + kk]; if (nscale) v *= nscale[n0 + n]; scr[kk * 33 + n] = v; }
    LDS_WAIT(); asm volatile("" ::: "memory");
    const int c = lane & 7;
#pragma unroll
    for (int j = 0; j < 4; ++j) { const int n = (lane >> 3) + 8 * j; const LAS float* s = scr + (8 * c) * 33 + n;
        u32x4 o; o.x = cvt_pk_bf16(s[0 * 33], s[1 * 33]); o.y = cvt_pk_bf16(s[2 * 33], s[3 * 33]); o.z = cvt_pk_bf16(s[4 * 33], s[5 * 33]); o.w = cvt_pk_bf16(s[6 * 33], s[7 * 33]);
        *(u32x4*)(WT + (size_t)(out_row0 + n) * pitch + k0 + 8 * c) = o; }
    LDS_WAIT(); asm volatile("" ::: "memory");
}
__device__ __forceinline__ void rms_row_to_bf16(const float* xrow, const float* gain, bf16* orow, int lane) {
    const f32x4* xr = (const f32x4*)xrow + lane; const f32x4* gr = (const f32x4*)gain + lane;
    f32x4 v[4]; float s = 0.f;
#pragma unroll
    for (int j = 0; j < 4; ++j) { v[j] = xr[64 * j]; s += (v[j].x * v[j].x + v[j].y * v[j].y) + (v[j].z * v[j].z + v[j].w * v[j].w); }
    const float rstd = 1.0f / sqrtf(wave_sum(s) * (1.f / 1024.f) + 1e-6f);
    u32x2* o8 = (u32x2*)orow + lane;
#pragma unroll
    for (int j = 0; j < 4; ++j) { const f32x4 g = gr[64 * j]; u32x2 w; w.x = cvt_pk_bf16(v[j].x * rstd * g.x, v[j].y * rstd * g.y); w.y = cvt_pk_bf16(v[j].z * rstd * g.z, v[j].w * rstd * g.w); o8[64 * j] = w; }
}
struct P0Args { const float *xp, *xs, *meta, *gmix, *win, *wout, *wup, *wdn, *gffn, *poolw, *pools, *spool, *sconv; bf16 *WIN, *WOUT, *WUP, *WDN, *WPOOL, *H, *Kb, *VT; float* out; };
__device__ __forceinline__ void p0_prologue(const Frame& F, const P0Args& a) {
    LAS float* scr = (LAS float*)(F.lds + RING_OFF + F.wave * 16384);
    const int gw = F.vcu * NWAVES + F.wave, NGW = F.G * NWAVES;
    constexpr int I_IN = 16 * 64, I_OUT = 16 * 32, I_UP = 16 * 176, I_DN = 44 * 32, I_POOL = 4 * 8;
    constexpr int NITEMS = I_IN + I_OUT + I_UP + I_DN + I_POOL;
    for (int it = gw; it < NITEMS; it += NGW) {
        int r = it;
        if (r < I_IN) { const int kb = r / 64, nb = r % 64; p0_transpose_item(a.win, 2048, a.WIN, 1024, 32 * nb, nullptr, nullptr, scr, 64 * kb, 32 * nb, F.lane); continue; } r -= I_IN;
        if (r < I_OUT) { const int kb = r / 32, nb = r % 32; p0_transpose_item(a.wout, 1024, a.WOUT, 1024, 32 * nb, nullptr, nullptr, scr, 64 * kb, 32 * nb, F.lane); continue; } r -= I_OUT;
        if (r < I_UP) { const int kb = r / 176, nb = r % 176; const int ch = 32 * nb, bj = ch / DFF, cc = ch % DFF;
            p0_transpose_item(a.wup, DUP, a.WUP, 1024, (cc / 128) * 256 + bj * 128 + (cc % 128), a.gffn, nullptr, scr, 64 * kb, 32 * nb, F.lane); continue; } r -= I_UP;
        if (r < I_DN) { const int kb = r / 32, nb = r % 32; p0_transpose_item(a.wdn, 1024, a.WDN, DFF, 32 * nb, nullptr, nullptr, scr, 64 * kb, 32 * nb, F.lane); continue; } r -= I_DN;
        { const int g = r / 8, q = r % 8, kb = q / 4, nb = q % 4; p0_transpose_item(a.poolw + (size_t)g * 128 * 128, 128, a.WPOOL + (size_t)g * 128 * 128, 128, 32 * nb, nullptr, a.pools + g * 128, scr, 64 * kb, 32 * nb, F.lane); }
    }
    for (int m = gw; m < NROWS; m += NGW) {
        const float* src = m < ROW_META ? a.xp + (size_t)m * DM : (m < ROW_SAMP ? a.meta + (size_t)(m - ROW_META) * DM : a.xs + (size_t)(m - ROW_SAMP) * DM);
        rms_row_to_bf16(src, a.gmix, a.H + (size_t)m * DM, F.lane);
    }
    const int gt = F.vcu * 512 + F.tid, NGT = F.G * 512;
    const u32x4 z4 = {0u, 0u, 0u, 0u};
    for (int i = gt; i < 4096; i += NGT) {
        { const int bh = i >> 7, q = i & 127; *(u32x4*)(a.Kb + (size_t)bh * KSTREAM * 64 + q * 8) = z4; }
        { const int bh = i >> 7, q = i & 127, d = q >> 1, hlf = q & 1; *(u32x4*)(a.VT + ((size_t)bh * NKT * 64 + d) * 32 + hlf * 8) = z4; }
    }
    for (int i = gt; i < DBATCH * 14 * 512; i += NGT) { const int s = i / (14 * 512), r = i % (14 * 512); a.out[O_POOLS + (size_t)s * 15 * 512 + r] = a.spool[(size_t)s * 15 * 512 + 512 + r]; }
    for (int i = gt; i < DBATCH * DUP; i += NGT) { const int s = i / DUP, c = i % DUP; a.out[O_CONVS + (size_t)s * 2 * DUP + c] = a.sconv[(size_t)s * 2 * DUP + DUP + c]; }
}

template <int NT>
__device__ __forceinline__ void small_gemm48(const Frame& F, const bf16* A, int lda, const bf16* Bt, int K, const int (&rb)[NT]) {
    const int fr = F.lane & 15, fq = F.lane >> 4;
    const int ksl = K / 8, k0 = F.wave * ksl;
    f32x4 acc[3][NT];
#pragma unroll
    for (int rt = 0; rt < 3; ++rt)
#pragma unroll
        for (int j = 0; j < NT; ++j) acc[rt][j] = (f32x4){0.f, 0.f, 0.f, 0.f};
    for (int ks = 0; ks < ksl; ks += 32) {
        const int kk = k0 + ks + 8 * fq;
        bf16x8 af[3], bfr[NT];
#pragma unroll
        for (int rt = 0; rt < 3; ++rt) af[rt] = *(const bf16x8*)(A + (size_t)(16 * rt + fr) * lda + kk);
#pragma unroll
        for (int j = 0; j < NT; ++j) bfr[j] = *(const bf16x8*)(Bt + (size_t)(rb[j] + fr) * K + kk);
#pragma unroll
        for (int rt = 0; rt < 3; ++rt)
#pragma unroll
            for (int j = 0; j < NT; ++j) acc[rt][j] = __builtin_amdgcn_mfma_f32_16x16x32_bf16(af[rt], bfr[j], acc[rt][j], 0, 0, 0);
    }
    LAS float* P = (LAS float*)(F.lds + RING_OFF);
    LAS float* T = (LAS float*)(F.lds + RING_OFF + 65536);
    constexpr int W = 16 * NT;
    __syncthreads();
#pragma unroll
    for (int rt = 0; rt < 3; ++rt)
#pragma unroll
        for (int j = 0; j < NT; ++j)
#pragma unroll
            for (int e = 0; e < 4; ++e) P[(F.wave * 48 + 16 * rt + 4 * fq + e) * W + 16 * j + fr] = acc[rt][j][e];
    __syncthreads();
    for (int idx = F.tid; idx < 48 * W; idx += 512) { float s = 0.f;
#pragma unroll
        for (int w = 0; w < 8; ++w) s += P[w * 48 * W + idx];
        T[idx] = s; }
    __syncthreads();
}

__device__ __forceinline__ bf16x8 pack8v(const f32x16& x, int s) {
    u32x4 p; p.x = cvt_pk_bf16(x[8 * s + 0], x[8 * s + 1]); p.y = cvt_pk_bf16(x[8 * s + 2], x[8 * s + 3]); p.z = cvt_pk_bf16(x[8 * s + 4], x[8 * s + 5]); p.w = cvt_pk_bf16(x[8 * s + 6], x[8 * s + 7]);
    return __builtin_bit_cast(bf16x8, p);
}
#define MFMA32(a, b, c) __builtin_amdgcn_mfma_f32_32x32x16_bf16((a), (b), (c), 0, 0, 0)
__device__ __forceinline__ void att_a1(const LAS unsigned char* kb, const bf16x8 (&qf)[4], const f32x16& c0v, f32x16& z, int r32, int hi) {
    z = c0v;
#pragma unroll
    for (int ks = 0; ks < 4; ++ks) { const bf16x8 a = *(const LAS bf16x8*)(kb + r32 * 128 + (((2 * ks + hi) ^ (r32 & 7)) << 4)); z = MFMA32(a, qf[ks], z); }
}
template <bool MASKED>
__device__ __forceinline__ void att_a2(const bf16x8 (&uf)[2], const bf16x8& ones, f32x16& tot, const f32x16& z, f32x16& cum, int hi, int lim_hi, int lim_lo) {
    f32x16 sp;
#pragma unroll
    for (int i = 0; i < 16; ++i) { const float e = __builtin_amdgcn_exp2f(z[i]); const float l = __builtin_amdgcn_logf(1.0f + e);
        if (MASKED) { const int kr = (i & 3) + 8 * (i >> 2) + 4 * hi; sp[i] = (kr < lim_hi && kr >= lim_lo) ? l : 0.f; } else sp[i] = l; }
    const bf16x8 sp0 = pack8v(sp, 0), sp1 = pack8v(sp, 1);
    cum = MFMA32(uf[0], sp0, tot); cum = MFMA32(uf[1], sp1, cum);
    tot = MFMA32(ones, sp0, tot); tot = MFMA32(ones, sp1, tot);
}
template <bool MASKED>
__device__ __forceinline__ void att_b(const LAS unsigned char* vb, const f32x16& z, const f32x16& cum, f32x16& o0, f32x16& o1, int r32, int hi, int lim_hi, int lim_lo) {
    f32x16 av;
#pragma unroll
    for (int i = 0; i < 16; ++i) { const float p = __builtin_amdgcn_exp2f(z[i] - cum[i]);
        if (MASKED) { const int kr = (i & 3) + 8 * (i >> 2) + 4 * hi; av[i] = (kr < lim_hi && kr >= lim_lo) ? p : 0.f; } else av[i] = p; }
    const bf16x8 a0 = pack8v(av, 0), a1 = pack8v(av, 1);
    { const int d = r32;      const bf16x8 v0 = *(const LAS bf16x8*)(vb + d * 64 + (((0 + hi) ^ ((d >> 2) & 3)) << 4)), v1 = *(const LAS bf16x8*)(vb + d * 64 + (((2 + hi) ^ ((d >> 2) & 3)) << 4)); o0 = MFMA32(v0, a0, o0); o0 = MFMA32(v1, a1, o0); }
    { const int d = 32 + r32; const bf16x8 v0 = *(const LAS bf16x8*)(vb + d * 64 + (((0 + hi) ^ ((d >> 2) & 3)) << 4)), v1 = *(const LAS bf16x8*)(vb + d * 64 + (((2 + hi) ^ ((d >> 2) & 3)) << 4)); o1 = MFMA32(v0, a0, o1); o1 = MFMA32(v1, a1, o1); }
}
__device__ __forceinline__ void attn_block(const Frame& F, const bf16* Q, const bf16* Kb, const bf16* VT, bf16* Mix, float c0, int b, int h, int J0, int nq) {
    const int lane = F.lane, wave = F.wave;
    const int r32 = lane & 31, hi = lane >> 5;
    const int J = J0 + wave; const bool act = wave < nq;
    const int bh = b * 8 + h;
    const int pr = 32 * J + r32;
    const int qrow = (pr >= 32) ? (b * SEQ + pr - 32) : (ROW_META + (pr & 15));
    bf16x8 qf[4];
#pragma unroll
    for (int s = 0; s < 4; ++s) qf[s] = *(const bf16x8*)(Q + (size_t)(act ? qrow : 0) * 512 + h * 64 + 16 * s + 8 * hi);
    bf16x8 uf[2], ones;
#pragma unroll
    for (int ks = 0; ks < 2; ++ks)
#pragma unroll
        for (int j = 0; j < 8; ++j) uf[ks][j] = ((16 * ks + 8 * (j >> 2) + 4 * hi + (j & 3)) >= r32) ? (short)0x3F80 : (short)0;
#pragma unroll
    for (int j = 0; j < 8; ++j) ones[j] = (short)0x3F80;
    f32x16 c0v, tot, o0, o1, zA, zB, cumA, cumB;
#pragma unroll
    for (int i = 0; i < 16; ++i) { c0v[i] = c0; tot[i] = 0.f; o0[i] = 0.f; o1[i] = 0.f; zA[i] = 0.f; zB[i] = 0.f; cumA[i] = 0.f; cumB[i] = 0.f; }
    const int jtop = J0 + nq - 1, nt = jtop + 1;
    const int tS = act ? jtop - J : nt;
    const char* src; int dsto;
    if (wave < 4) { const int row = 8 * wave + (lane >> 3), ch = lane & 7; src = (const char*)(Kb + (size_t)bh * KSTREAM * 64) + row * 128 + ((ch ^ (row & 7)) << 4); dsto = wave * 1024; }
    else { const int d = 16 * (wave - 4) + (lane >> 2), ch = lane & 3; src = (const char*)(VT + (size_t)bh * NKT * 2048) + d * 64 + ((ch ^ ((d >> 2) & 3)) << 4); dsto = 4096 + (wave - 4) * 1024; }
    LAS unsigned char* ring = F.lds + RING_OFF;
#define ATT_DMA(t) __builtin_amdgcn_global_load_lds((const unsigned*)(src + (size_t)(jtop - (t)) * 4096), (LAS unsigned*)(ring + ((t) & 3) * 8192 + dsto), 16, 0, 0)
#define ATT_LIMS(t, lh, ll) const int lh = ((t) == tS) ? r32 : 32, ll = ((t) == nt - 1) ? 16 : 0
    ATT_DMA(0);
    if (nt > 1) ATT_DMA(1);
    if (nt > 2) ATT_DMA(2);
    if (nt > 2) asm volatile("s_waitcnt vmcnt(2)" ::: "memory"); else if (nt > 1) asm volatile("s_waitcnt vmcnt(1)" ::: "memory"); else asm volatile("s_waitcnt vmcnt(0)" ::: "memory");
    __builtin_amdgcn_s_barrier(); asm volatile("" ::: "memory");
    if (tS == 0) { ATT_LIMS(0, lh, ll); att_a1(ring, qf, c0v, zA, r32, hi); att_a2<true>(uf, ones, tot, zA, cumA, hi, lh, ll); }
#define ATT_ITER(t, zC, cumC, zN, cumN) do { \
        if ((t) + 1 < nt) { if ((t) + 2 < nt) asm volatile("s_waitcnt vmcnt(1)" ::: "memory"); else asm volatile("s_waitcnt vmcnt(0)" ::: "memory"); } \
        __builtin_amdgcn_s_barrier(); asm volatile("" ::: "memory"); \
        if ((t) + 3 < nt) ATT_DMA((t) + 3); \
        const LAS unsigned char* kbn = ring + (((t) + 1) & 3) * 8192; const LAS unsigned char* vbc = ring + ((t) & 3) * 8192 + 4096; \
        if ((t) > tS && (t) + 2 < nt) { \
            att_a1(kbn, qf, c0v, zN, r32, hi); att_b<false>(vbc, zC, cumC, o0, o1, r32, hi, 32, 0); att_a2<false>(uf, ones, tot, zN, cumN, hi, 32, 0); \
        } else { \
            const bool doA = ((t) + 1 < nt) && ((t) + 1 >= tS), doB = (t) >= tS && (t) < nt; \
            if (doA) att_a1(kbn, qf, c0v, zN, r32, hi); \
            if (doB) { ATT_LIMS((t), lh, ll); att_b<true>(vbc, zC, cumC, o0, o1, r32, hi, lh, ll); } \
            if (doA) { ATT_LIMS((t) + 1, lh, ll); att_a2<true>(uf, ones, tot, zN, cumN, hi, lh, ll); } \
        } \
        asm volatile("s_waitcnt lgkmcnt(0)" ::: "memory"); } while (0)
    for (int t = 0; t < nt; t += 2) {
        ATT_ITER(t, zA, cumA, zB, cumB);
        if (t + 1 < nt) ATT_ITER(t + 1, zB, cumB, zA, cumA);
    }
#undef ATT_ITER
#undef ATT_LIMS
#undef ATT_DMA
    if (act && (J >= 1 || (b == 0 && r32 >= 16))) {
        bf16* ob = Mix + (size_t)qrow * 1024 + h * 64;
#pragma unroll
        for (int g = 0; g < 4; ++g) {
            u32x2 w0; w0.x = cvt_pk_bf16(o0[4 * g], o0[4 * g + 1]); w0.y = cvt_pk_bf16(o0[4 * g + 2], o0[4 * g + 3]); *(u32x2*)(ob + 8 * g + 4 * hi) = w0;
            u32x2 w1; w1.x = cvt_pk_bf16(o1[4 * g], o1[4 * g + 1]); w1.y = cvt_pk_bf16(o1[4 * g + 2], o1[4 * g + 3]); *(u32x2*)(ob + 32 + 8 * g + 4 * hi) = w1;
        }
    }
    __builtin_amdgcn_s_barrier(); asm volatile("" ::: "memory");
}

template <int W>
__device__ __forceinline__ void pool_rows(const float* U, int b, int t0, int col, LAS bf16* dT, int lane) {
    f32x2 ring[W]; f32x2 S = {0.f, 0.f};
#pragma unroll
    for (int i = 0; i < W; ++i) ring[i] = (f32x2){0.f, 0.f};
#pragma unroll
    for (int j = -(W - 1); j < 32; ++j) {
        const int tt = t0 + j;
        const int srow = tt >= 0 ? b * SEQ + tt : ROW_META + 16 + tt;
        const f32x2 v = *(const f32x2*)(U + (size_t)srow * 512 + col);
        const int slot = (j + W - 1) % W;
        S = S + (v - ring[slot]); ring[slot] = v;
        if (j >= 0) { const f32x2 d = S * (1.0f / W) - v; *(LAS unsigned*)(dT + j * 136 + 2 * lane) = cvt_pk_bf16(d.x, d.y); }
    }
}
__device__ __forceinline__ void pool_unit(const Frame& F, const float* U, const bf16* WPOOL, bf16* Mix, int pm, int g) {
    const int lane = F.lane, fr = lane & 15, fq = lane >> 4;
    LAS bf16* dT = (LAS bf16*)(F.lds + RING_OFF + F.wave * 8704);
    const int row0 = pm * 256 + F.wave * 32, b = row0 >> 12, t0 = row0 & 4095, col = 128 * g + 2 * lane;
    if (g == 0) pool_rows<2>(U, b, t0, col, dT, lane); else if (g == 1) pool_rows<4>(U, b, t0, col, dT, lane); else if (g == 2) pool_rows<8>(U, b, t0, col, dT, lane); else pool_rows<16>(U, b, t0, col, dT, lane);
    LDS_WAIT(); asm volatile("" ::: "memory");
    bf16x8 af[2][4];
#pragma unroll
    for (int rt = 0; rt < 2; ++rt)
#pragma unroll
        for (int ks = 0; ks < 4; ++ks) af[rt][ks] = *(const LAS bf16x8*)(dT + (16 * rt + fr) * 136 + 32 * ks + 8 * fq);
    const bf16* wp = WPOOL + (size_t)g * 128 * 128;
#pragma unroll 2
    for (int ct = 0; ct < 8; ++ct) {
        bf16x8 bfr[4];
#pragma unroll
        for (int ks = 0; ks < 4; ++ks) bfr[ks] = *(const bf16x8*)(wp + (size_t)(16 * ct + fr) * 128 + 32 * ks + 8 * fq);
#pragma unroll
        for (int rt = 0; rt < 2; ++rt) {
            f32x4 acc = {0.f, 0.f, 0.f, 0.f};
#pragma unroll
            for (int ks = 0; ks < 4; ++ks) acc = __builtin_amdgcn_mfma_f32_16x16x32_bf16(bfr[ks], af[rt][ks], acc, 0, 0, 0);
            u32x2 w; w.x = cvt_pk_bf16(acc[0], acc[1]); w.y = cvt_pk_bf16(acc[2], acc[3]);
            *(u32x2*)(Mix + (size_t)(row0 + 16 * rt + fr) * 1024 + 512 + 128 * g + 16 * ct + 4 * fq) = w;
        }
    }
    LDS_WAIT(); asm volatile("" ::: "memory");
}

template <int CTRL> __device__ __forceinline__ float dppf(float x) { return __builtin_bit_cast(float, __builtin_amdgcn_mov_dpp(__builtin_bit_cast(int, x), CTRL, 0xf, 0xf, true)); }
__device__ __forceinline__ float readlane_f(float x, int l) { return __builtin_bit_cast(float, __builtin_amdgcn_readlane(__builtin_bit_cast(int, x), l)); }
__device__ __forceinline__ float row16_sum(float x) {
    x += dppf<0xB1>(x); x += dppf<0x4E>(x); x += dppf<0x141>(x); x += dppf<0x128>(x); return x;
}
__device__ __forceinline__ void decode_item(const float* QS, const float* ck, const float* cv, const int* ptab, float* PO, float* PT, float c0, int b, int pg, int h, int lane) {
    const int c = lane & 15, g = lane >> 4;
    const f32x4 q = *(const f32x4*)(QS + b * 512 + h * 64 + 4 * c);
    float carry = 0.f; f32x4 oacc = {0.f, 0.f, 0.f, 0.f};
    for (int pi = 3; pi >= 0; --pi) {
        const int page = ptab[b * NPAGES + 4 * pg + pi];
        const size_t base = (((size_t)page * 128 + 32 * g) * 8 + h) * 64 + 4 * c;
        const float* kb = ck + base; const float* vb = cv + base;
        float S = 0.f; f32x4 acc = {0.f, 0.f, 0.f, 0.f};
#pragma unroll 8
        for (int i = 31; i >= 0; --i) {
            const f32x4 kv = __builtin_nontemporal_load((const f32x4*)(kb + i * 512));
            const f32x4 vv = __builtin_nontemporal_load((const f32x4*)(vb + i * 512));
            float d = (kv.x * q.x + kv.y * q.y) + (kv.z * q.z + kv.w * q.w);
            d = row16_sum(d);
            const float z = d + c0, e = __builtin_amdgcn_exp2f(z), sp = __builtin_amdgcn_logf(1.0f + e);
            S += sp;
            const float a = __builtin_amdgcn_exp2f(z - S);
            acc = acc + vv * a;
        }
        const float t0 = readlane_f(S, 0), t1 = readlane_f(S, 16), t2 = readlane_f(S, 32), t3 = readlane_f(S, 48);
        const float corr = carry + (g < 3 ? t3 : 0.f) + (g < 2 ? t2 : 0.f) + (g < 1 ? t1 : 0.f);
        oacc = oacc + acc * __builtin_amdgcn_exp2f(-corr);
        carry += (t0 + t1) + (t2 + t3);
    }
#pragma unroll
    for (int k = 0; k < 4; ++k) { float v = oacc[k]; v += __shfl_xor(v, 16); v += __shfl_xor(v, 32); oacc[k] = v; }
    const int it = b * 16 + pg;
    if (g == 0) *(f32x4*)(PO + ((size_t)it * 8 + h) * 64 + 4 * c) = oacc;
    if (lane == 0) PT[it * 8 + h] = carry;
}

__device__ __forceinline__ void side_pool(const Frame& F, const float* U, const float* spool, const bf16* WPOOL, bf16* Mix) {
    LAS bf16* dS = (LAS bf16*)(F.lds + RING_OFF);
    for (int idx = F.tid; idx < 48 * 256; idx += 512) {
        const int r = idx >> 8, col = 2 * (idx & 255), g = col >> 7, W = 2 << g;
        f32x2 s = {0.f, 0.f}, cur; float inv;
        if (r < 16) { const int cnt = (r + 1) < W ? (r + 1) : W; cur = *(const f32x2*)(U + (size_t)(ROW_META + r) * 512 + col);
            for (int i = 0; i < cnt; ++i) s = s + *(const f32x2*)(U + (size_t)(ROW_META + r - i) * 512 + col);
            inv = 1.0f / (float)cnt; }
        else { const int sm = r - 16; cur = *(const f32x2*)(U + (size_t)(ROW_SAMP + sm) * 512 + col); s = cur;
            for (int i = 1; i < W; ++i) s = s + *(const f32x2*)(spool + ((size_t)sm * 15 + (15 - i)) * 512 + col);
            inv = 1.0f / (float)W; }
        const f32x2 d = s * inv - cur;
        *(LAS unsigned*)(dS + r * 520 + col) = cvt_pk_bf16(d.x, d.y);
    }
    __syncthreads();
    const int fr = F.lane & 15, fq = F.lane >> 4;
    for (int p = F.wave; p < 96; p += 8) {
        const int rt = p / 32, ct = p % 32, g = ct >> 3;
        f32x4 acc = {0.f, 0.f, 0.f, 0.f};
#pragma unroll
        for (int ks = 0; ks < 4; ++ks) {
            const bf16x8 a = *(const LAS bf16x8*)(dS + (16 * rt + fr) * 520 + 128 * g + 32 * ks + 8 * fq);
            const bf16x8 bq = *(const bf16x8*)(WPOOL + ((size_t)g * 128 + 16 * (ct & 7) + fr) * 128 + 32 * ks + 8 * fq);
            acc = __builtin_amdgcn_mfma_f32_16x16x32_bf16(bq, a, acc, 0, 0, 0);
        }
        u32x2 w; w.x = cvt_pk_bf16(acc[0], acc[1]); w.y = cvt_pk_bf16(acc[2], acc[3]);
        *(u32x2*)(Mix + (size_t)(ROW_META + 16 * rt + fr) * 1024 + 512 + 16 * ct + 4 * fq) = w;
    }
    __syncthreads();
}

struct Args { const void* in[20]; float* out; unsigned char* ws; };

__global__ void __launch_bounds__(NWAVES * 64, 2) hymba_fwd(Args args) {
    extern __shared__ __attribute__((aligned(16))) unsigned char lds[];
    Frame F;
    F.lds = (LAS unsigned char*)lds;
    F.MISC = (volatile LAS unsigned*)(F.lds + MISC_OFF);
    F.tid = threadIdx.x; F.lane = F.tid & 63; F.wave = __builtin_amdgcn_readfirstlane(F.tid >> 6);
    F.G = gridDim.x; { const int bx = blockIdx.x; F.vcu = (F.G % 8 == 0) ? (bx % 8) * (F.G / 8) + bx / 8 : bx; }
    typedef __attribute__((address_space(4))) const Args CArgs;
    CArgs* const KA = (CArgs*)__builtin_amdgcn_kernarg_segment_ptr();
#define PHASE_PTRS() CArgs* A_ = KA; asm volatile("" : "+s"(A_)); unsigned char* const ws = A_->ws; float* const out = A_->out; (void)ws; (void)out; \
    { int t_ = threadIdx.x; asm volatile("" : "+v"(t_)); F.tid = t_; F.lane = t_ & 63; }
#define INP(T, i) ((const T*)A_->in[i])
#define x_prompt INP(float, 0)
#define x_sample INP(float, 1)
#define cache_k INP(float, 2)
#define cache_v INP(float, 3)
#define state_pool INP(float, 4)
#define state_conv INP(float, 5)
#define page_table INP(int, 6)
#define meta_tokens INP(float, 7)
#define norm_mix_g INP(float, 8)
#define w_in INP(float, 9)
#define sb_bias INP(float, 10)
#define pool_w INP(float, 11)
#define pool_scale INP(float, 12)
#define w_out INP(float, 13)
#define norm_ffn_g INP(float, 14)
#define w_up INP(float, 15)
#define conv_w INP(float, 16)
#define conv_b INP(float, 17)
#define w_down INP(float, 18)
#define norm_final_g INP(float, 19)
#define WIN ((bf16*)(ws + WS_WIN))
#define WOUT ((bf16*)(ws + WS_WOUT))
#define WUP ((bf16*)(ws + WS_WUP))
#define WDN ((bf16*)(ws + WS_WDN))
#define WPOOL ((bf16*)(ws + WS_WPOOL))
#define QS ((float*)(ws + WS_QS))
#define PT ((float*)(ws + WS_PT))
#define ST1S ((float*)(ws + WS_ST1S))
#define ST2S ((float*)(ws + WS_ST2S))
#define PO ((float*)(ws + WS_PO))
#define ST1 ((float*)(ws + WS_ST1))
#define ST2 ((float*)(ws + WS_ST2))
#define Hb ((bf16*)(ws + WS_H))
#define Qb ((bf16*)(ws + WS_Q))
#define Kb ((bf16*)(ws + WS_K))
#define VT ((bf16*)(ws + WS_VT))
#define Ub ((float*)(ws + WS_U))
#define Mix ((bf16*)(ws + WS_MIX))
#define X1F ((float*)(ws + WS_X1F))
#define X1B ((bf16*)(ws + WS_X1B))
#define Gb ((bf16*)(ws + WS_G))
#define X2F ((float*)(ws + WS_X2F))
#define FBb ((float*)(ws + WS_FB))
#define HBb ((float*)(ws + WS_HB))
#define HMb ((float*)(ws + WS_HM))

    for (int u = F.tid; u < (LDS_BYTES - LDSCTL_OFF) / 4; u += NWAVES * 64) ((LAS unsigned*)(F.lds + LDSCTL_OFF))[u] = 0u;
    __syncthreads();
    XcdBarrier bar; { PHASE_PTRS(); bar = xcd_barrier_post((unsigned*)(ws + WS_CTL) + CW_BAR, F.MISC + 8); }
    LAS float* T = (LAS float*)(F.lds + RING_OFF + 65536);

    { PHASE_PTRS();
    {
        P0Args a{x_prompt, x_sample, meta_tokens, norm_mix_g, w_in, w_out, w_up, w_down, norm_ffn_g, pool_w, pool_scale, state_pool, state_conv, WIN, WOUT, WUP, WDN, WPOOL, Hb, Kb, VT, out};
        p0_prologue(F, a);
    }
    }
    xcd_barrier(bar);

    { PHASE_PTRS();
    for (int it = blockIdx.x; it < 128; it += F.G) {
        const int rb[1] = {16 * it};
        small_gemm48<1>(F, Hb + (size_t)ROW_META * DM, DM, WIN, DM, rb);
        const int kind = it >> 5;
        for (int idx = F.tid; idx < 768; idx += 512) {
            const int r = idx >> 4, c = idx & 15, cc = (16 * it + c) & 511, head = cc >> 6, d = cc & 63; const float v = T[idx];
            if (r < 16) {
                if (kind == 0) Qb[(size_t)(ROW_META + r) * 512 + cc] = f2bf(v * QSCALE);
                else if (kind == 3) Ub[(size_t)(ROW_META + r) * 512 + cc] = v;
                else {
                    const bf16 hv = f2bf(v);
#pragma unroll
                    for (int b = 0; b < NB; ++b) {
                        out[(kind == 1 ? O_KP : O_VP) + ((size_t)(b * TT + r) * 8 + head) * 64 + d] = v;
                        if (kind == 1) Kb[((size_t)(b * 8 + head) * KSTREAM + 16 + r) * 64 + d] = hv;
                        else VT[(((size_t)(b * 8 + head) * NKT + 0) * 64 + d) * 32 + 16 + perm16(r)] = hv;
                    }
                }
            } else {
                const int s = r - 16;
                if (kind == 0) QS[s * 512 + cc] = v * QSCALE;
                else if (kind == 1) out[O_KS + s * 512 + cc] = v;
                else if (kind == 2) out[O_VS + s * 512 + cc] = v;
                else { Ub[(size_t)(ROW_SAMP + s) * 512 + cc] = v; out[O_POOLS + ((size_t)s * 15 + 14) * 512 + cc] = v; }
            }
        }
    }
    __syncthreads();
    {
        pg8::Gemm g{Hb, WIN, MREAL, 2048, DM}; pg8::StaticOrder S; S.init(MREAL, 2048, F.G, (int)blockIdx.x);
        pg8::EpiIn E{Qb, Kb, VT, Ub, out + O_KP, out + O_VP, out + O_POOLP, QSCALE};
        pg8::gemm_phase<pg8::EpiIn, pg8::StaticOrder, true, true>(F.lds + RING_OFF, g, S, E);
    }
    }
    xcd_barrier(bar);

    { PHASE_PTRS();
    if ((F.vcu & 1) == 0)
        for (int it = F.vcu; it < 512; it += F.G)
            decode_item(QS, cache_k, cache_v, page_table, PO, PT, sb_bias[F.wave] * LOG2E, it >> 4, it & 15, F.wave, F.lane);
    {
        const int st = F.vcu >> 3, p = F.vcu & 7, b = st >> 3, h = st & 7;
        const float c0 = sb_bias[h] * LOG2E;
        attn_block(F, Qb, Kb, VT, Mix, c0, b, h, 8 * (15 - p) + 1, 8);
        attn_block(F, Qb, Kb, VT, Mix, c0, b, h, 8 * p + 1, 8);
        if (p == 0 && b == 0) attn_block(F, Qb, Kb, VT, Mix, c0, b, h, 0, 1);
    }
    pool_unit(F, Ub, WPOOL, Mix, F.vcu >> 2, F.vcu & 3);
    __syncthreads();
    if ((F.vcu & 1) != 0)
        for (int it = F.vcu; it < 512; it += F.G)
            decode_item(QS, cache_k, cache_v, page_table, PO, PT, sb_bias[F.wave] * LOG2E, it >> 4, it & 15, F.wave, F.lane);
    }
    xcd_barrier(bar);

    { PHASE_PTRS();
    {
        const int gw = F.vcu * NWAVES + F.wave;
        if (gw < 256) { const int b = gw >> 3, h = gw & 7; float run = 0.f, o = 0.f;
            for (int pg = 15; pg >= 0; --pg) { const int it = b * 16 + pg; o += __builtin_amdgcn_exp2f(-run) * PO[((size_t)it * 8 + h) * 64 + F.lane]; run += PT[it * 8 + h]; }
            Mix[(size_t)(ROW_SAMP + b) * 1024 + h * 64 + F.lane] = f2bf(o); }
        if (F.vcu == F.G - 1) side_pool(F, Ub, state_pool, WPOOL, Mix);
    }
    }
    xcd_barrier(bar);

    { PHASE_PTRS();
    for (int it = blockIdx.x; it < 64; it += F.G) {
        const int rb[1] = {16 * it};
        small_gemm48<1>(F, Mix + (size_t)ROW_META * 1024, 1024, WOUT, DM, rb);
        for (int idx = F.tid; idx < 768; idx += 512) {
            const int r = idx >> 4, c = idx & 15, col = 16 * it + c;
            const float x = T[idx] + (r < 16 ? meta_tokens[(size_t)r * DM + col] : x_sample[(size_t)(r - 16) * DM + col]);
            X1F[(size_t)(ROW_META + r) * DM + col] = x; X1B[(size_t)(ROW_META + r) * DM + col] = f2bf(x); T[idx] = x * x;
        }
        __syncthreads();
        if (F.tid < 48) { float s = 0.f;
#pragma unroll
            for (int c = 0; c < 16; ++c) s += T[F.tid * 16 + c];
            ST1S[F.tid * 64 + it] = s; }
    }
    __syncthreads();
    {
        pg8::Gemm g{Mix, WOUT, MREAL, DM, DM}; pg8::StaticOrder S; S.init(MREAL, DM, F.G, (int)blockIdx.x);
        pg8::EpiOut E{x_prompt, X1F, X1B, ST1};
        pg8::gemm_phase<pg8::EpiOut, pg8::StaticOrder, false, true>(F.lds + RING_OFF, g, S, E);
    }
    }
    xcd_barrier(bar);

    { PHASE_PTRS();
    {
        LAS float* rr = (LAS float*)(F.lds + RING_OFF + 65536 + 8192);
        LAS float* T2 = (LAS float*)(F.lds + RING_OFF + 65536);
        for (int it = blockIdx.x; it < 176; it += F.G) {
            const int c0 = 16 * it, rb[2] = {(c0 >> 7) * 256 + (c0 & 127), (c0 >> 7) * 256 + (c0 & 127) + 128};
            small_gemm48<2>(F, X1B + (size_t)ROW_META * DM, DM, WUP, DM, rb);
            if (F.tid < 48) { float sm = 0.f; for (int i = 0; i < 64; ++i) sm += ST1S[F.tid * 64 + i]; rr[F.tid] = 1.0f / sqrtf(sm * (1.f / 1024.f) + 1e-6f); }
            __syncthreads();
            for (int idx = F.tid; idx < 48 * 32; idx += 512) T2[idx] *= rr[idx >> 5];
            __syncthreads();
            for (int idx = F.tid; idx < 768; idx += 512) {
                const int r = idx >> 4, c = idx & 15, ch = c0 + c;
                const float xg = T2[r * 32 + c], xv = T2[r * 32 + 16 + c];
                float g1, g2, v1, v2;
                if (r < 16) { g1 = r >= 1 ? T2[(r - 1) * 32 + c] : 0.f; g2 = r >= 2 ? T2[(r - 2) * 32 + c] : 0.f; v1 = r >= 1 ? T2[(r - 1) * 32 + 16 + c] : 0.f; v2 = r >= 2 ? T2[(r - 2) * 32 + 16 + c] : 0.f;
                    if (r >= 14) { HMb[(size_t)(r - 14) * DUP + rb[0] + c] = xg; HMb[(size_t)(r - 14) * DUP + rb[1] + c] = xv; } }
                else { const int sm = r - 16; g2 = state_conv[((size_t)sm * 2 + 0) * DUP + ch]; g1 = state_conv[((size_t)sm * 2 + 1) * DUP + ch]; v2 = state_conv[((size_t)sm * 2 + 0) * DUP + DFF + ch]; v1 = state_conv[((size_t)sm * 2 + 1) * DUP + DFF + ch];
                    out[O_CONVS + ((size_t)sm * 2 + 1) * DUP + ch] = xg; out[O_CONVS + ((size_t)sm * 2 + 1) * DUP + DFF + ch] = xv; }
                const float cg = conv_b[ch] + conv_w[ch] * g2 + conv_w[DUP + ch] * g1 + conv_w[2 * DUP + ch] * xg;
                const float cv = conv_b[DFF + ch] + conv_w[DFF + ch] * v2 + conv_w[DUP + DFF + ch] * v1 + conv_w[2 * DUP + DFF + ch] * xv;
                Gb[(size_t)(ROW_META + r) * DFF + ch] = f2bf(pg8::silu_f(cg) * cv);
            }
        }
    }
    __syncthreads();
    {
        pg8::Gemm g{X1B, WUP, MREAL, DUP, DM}; pg8::StaticOrder S; S.init(MREAL, DUP, F.G, (int)blockIdx.x);
        pg8::EpiUpConv E{Gb, ST1, out + O_CONVP, conv_w, conv_b, FBb, HBb, (LAS float*)(F.lds + XCH_OFF)};
        pg8::gemm_phase<pg8::EpiUpConv, pg8::StaticOrder, true, true>(F.lds + RING_OFF, g, S, E);
    }
    }
    xcd_barrier(bar);

    { PHASE_PTRS();
    {
        pg8::StaticOrder S; S.init(MREAL, DM, F.G, (int)blockIdx.x); pg8::Unit u0;
        if (S.next(0, u0) && F.tid < 352) {
            const int pm = u0.pm, c = 8 * F.tid, pcg = (c >> 7) * 256 + (c & 127);
            const float* hp = (pm & 15) == 0 ? HMb : HBb + (size_t)(pm - 1) * 2 * DUP;
            const float* fp = FBb + (size_t)pm * 2 * DUP;
#pragma unroll
            for (int j = 0; j < 2; ++j) {
                const float* x2g = j == 0 ? hp : hp + DUP; const float* x1g = j == 0 ? hp + DUP : fp; const float* x0g = fp + j * DUP;
                float gg[8];
#pragma unroll
                for (int e = 0; e < 8; ++e) {
                    const float cg = conv_b[c + e] + conv_w[c + e] * x2g[pcg + e] + conv_w[DUP + c + e] * x1g[pcg + e] + conv_w[2 * DUP + c + e] * x0g[pcg + e];
                    const float cv = conv_b[DFF + c + e] + conv_w[DFF + c + e] * x2g[pcg + 128 + e] + conv_w[DUP + DFF + c + e] * x1g[pcg + 128 + e] + conv_w[2 * DUP + DFF + c + e] * x0g[pcg + 128 + e];
                    gg[e] = pg8::silu_f(cg) * cv;
                }
                u32x4 o; o.x = cvt_pk_bf16(gg[0], gg[1]); o.y = cvt_pk_bf16(gg[2], gg[3]); o.z = cvt_pk_bf16(gg[4], gg[5]); o.w = cvt_pk_bf16(gg[6], gg[7]);
                *(u32x4*)(Gb + (size_t)(pm * 256 + j) * DFF + c) = o;
            }
        }
        asm volatile("s_waitcnt vmcnt(0)" ::: "memory");
        __syncthreads();
    }
    for (int it = blockIdx.x; it < 64; it += F.G) {
        const int rb[1] = {16 * it};
        small_gemm48<1>(F, Gb + (size_t)ROW_META * DFF, DFF, WDN, DFF, rb);
        for (int idx = F.tid; idx < 768; idx += 512) {
            const int r = idx >> 4, c = idx & 15, col = 16 * it + c;
            const float x = T[idx] + X1F[(size_t)(ROW_META + r) * DM + col];
            X2F[(size_t)(ROW_META + r) * DM + col] = x; T[idx] = x * x;
        }
        __syncthreads();
        if (F.tid < 48) { float s = 0.f;
#pragma unroll
            for (int c = 0; c < 16; ++c) s += T[F.tid * 16 + c];
            ST2S[F.tid * 64 + it] = s; }
    }
    __syncthreads();
    {
        pg8::Gemm g{Gb, WDN, MREAL, DM, DFF}; pg8::StaticOrder S; S.init(MREAL, DM, F.G, (int)blockIdx.x);
        pg8::EpiDown E{X1F, X2F, ST2};
        pg8::gemm_phase<pg8::EpiDown, pg8::StaticOrder, false, true>(F.lds + RING_OFF, g, S, E);
    }
    }
    xcd_barrier(bar);

    { PHASE_PTRS();
    {
        const int gw = F.vcu * NWAVES + F.wave, NGW = F.G * NWAVES;
        for (int m = gw; m < MREAL + DBATCH; m += NGW) {
            float rs; const float* xr; float* yo;
            if (m < MREAL) { rs = pg8::row_rstd(ST2, m); xr = X2F + (size_t)m * DM; yo = out + O_YP + (size_t)m * DM; }
            else { const int s = m - MREAL; float t = ST2S[(16 + s) * 64 + F.lane]; t = wave_sum(t); rs = 1.0f / sqrtf(t * (1.f / 1024.f) + 1e-6f); xr = X2F + (size_t)(ROW_SAMP + s) * DM; yo = out + O_YS + (size_t)s * DM; }
#pragma unroll
            for (int j = 0; j < 4; ++j) { const f32x4 x = ((const f32x4*)xr)[F.lane + 64 * j], g = ((const f32x4*)norm_final_g)[F.lane + 64 * j]; ((f32x4*)yo)[F.lane + 64 * j] = x * rs * g; }
        }
    }
    }
}

extern "C" void kernel_launch(void* const* d_in, const int* in_sizes, int n_in, void* d_out, int out_size, void* d_ws, size_t ws_size, hipStream_t stream) {
    static int grid = 0;
    if (grid == 0) {
        if (n_in != 20 || ws_size < WS_END) { fprintf(stderr, "kernel_launch: unexpected shapes (n_in %d, out %d, ws %zu); nothing launched\n", n_in, out_size, ws_size); grid = -1; return; }
        int dev = 0, cus = 0, per_cu = 0;
        if (hipGetDevice(&dev) != hipSuccess || hipDeviceGetAttribute(&cus, hipDeviceAttributeMultiprocessorCount, dev) != hipSuccess) { grid = -1; return; }
        if (hipFuncSetAttribute((const void*)hymba_fwd, hipFuncAttributeMaxDynamicSharedMemorySize, LDS_BYTES) != hipSuccess) { fprintf(stderr, "kernel_launch: hipFuncSetAttribute failed\n"); grid = -1; return; }
        if (hipOccupancyMaxActiveBlocksPerMultiprocessor(&per_cu, (const void*)hymba_fwd, NWAVES * 64, LDS_BYTES) != hipSuccess || per_cu < 1)
            fprintf(stderr, "kernel_launch: note: occupancy query reports %d workgroups per CU\n", per_cu);
        (void)hipGetLastError();
        grid = cus;
        if (grid != 256) fprintf(stderr, "kernel_launch: note: %d CUs (built for 256)\n", grid);
    }
    if (grid < 0) return;
    if (hipMemsetAsync((char*)d_ws + WS_CTL, 0, CTL_ZERO_BYTES, stream) != hipSuccess) return;
    Args a{};
    for (int i = 0; i < 20; ++i) a.in[i] = d_in[i];
    a.out = (float*)d_out; a.ws = (unsigned char*)d_ws;
    hipLaunchKernelGGL(hymba_fwd, dim3(grid), dim3(NWAVES * 64), LDS_BYTES, stream, a);
}
```
